# Optimizing an MI355X kernel written in HIP

```python
import jax, jax.numpy as jnp
from jax import lax
import numpy as np

D_MODEL = 1024
BATCH = 8
SEQ = 8192
DEPTH = 4

CTX_LEN = 256
GRID_W = 64
EPS = 1e-6

F_GROUPS = 4
F_GROUP_DIM = D_MODEL // 16
F_WIDTH = F_GROUPS * F_GROUP_DIM
M_HEADS = 4
M_HEAD_DIM = D_MODEL // 16
M_WIDTH = M_HEADS * M_HEAD_DIM
M_CONV_W = 3
M_CHUNK = 128
M_GATES = 2 * 2 * M_HEADS
A_HEADS = 8
A_NOPE = D_MODEL // 16
A_ROPE = D_MODEL // 32
A_V = D_MODEL // 16
A_WIDTH = A_HEADS * A_V
Q_LORA = 3 * D_MODEL // 8
KV_LORA = D_MODEL // 4
ROPE_BASE = 10000.0
Q_BLOCK = 128
D_MIX = F_WIDTH + M_WIDTH + A_WIDTH
IN_SIZES = (F_WIDTH, 2 * M_WIDTH, M_WIDTH, M_WIDTH, M_GATES, Q_LORA, KV_LORA, A_ROPE)
IN_COLS = sum(IN_SIZES)
N_EXPERTS = 16
EC_FACTOR = 2
EXPERT_FF = D_MODEL

kernel_name = "hybrid_fnet_mlstm_mla_ec_diffusion"


def rms_norm(x, g):
    xf = x.astype(jnp.float32)
    y = xf * lax.rsqrt(jnp.mean(xf * xf, -1, keepdims=True) + EPS)
    return (y * g.astype(jnp.float32)).astype(x.dtype)


def modulated_rms(x, g, shift, scale):
    return rms_norm(x, g) * (1 + scale) + shift


def split_in(u):
    outs = []
    start = 0
    for size in IN_SIZES:
        outs.append(u[..., start:start + size])
        start += size
    return outs


def axial_rope(n, dtype):
    rows = n // GRID_W
    row_id = jnp.repeat(jnp.arange(rows, dtype=jnp.float32), GRID_W)
    col_id = jnp.tile(jnp.arange(GRID_W, dtype=jnp.float32), rows)
    n_freq = A_ROPE // 4
    inv = ROPE_BASE ** (-jnp.arange(n_freq, dtype=jnp.float32) / n_freq)
    ang = jnp.concatenate([row_id[:, None] * inv, col_id[:, None] * inv], -1)
    return jnp.cos(ang).astype(dtype), jnp.sin(ang).astype(dtype)


def apply_rope(t, cos, sin):
    half = A_ROPE // 2
    t1, t2 = t[..., :half], t[..., half:]
    cs, sn = cos[:, None, :], sin[:, None, :]
    return jnp.concatenate([t1 * cs - t2 * sn, t1 * sn + t2 * cs], -1)


def fourier_mix(u):
    b, t, _ = u.shape
    ug = u.astype(jnp.float32).reshape(b, t, F_GROUPS, F_GROUP_DIM)
    y = jnp.fft.fft2(ug, axes=(1, 3), norm="ortho").real
    return y.reshape(b, t, F_WIDTH).astype(u.dtype)


def centred_dwconv(u, w, bias):
    pad = (M_CONV_W - 1) // 2
    y = lax.conv_general_dilated(u, w[:, None, :], window_strides=(1,), padding=[(pad, pad)],
                                 dimension_numbers=("NWC", "WIO", "NWC"), feature_group_count=u.shape[-1])
    return y + bias


def mlstm_prepare(qk, v, gates, conv_w, conv_b, ib, fb):
    b, t, _ = v.shape
    qk = jax.nn.silu(centred_dwconv(qk, conv_w, conv_b))
    q, k = qk[..., :M_WIDTH], qk[..., M_WIDTH:]
    heads = lambda a: a.reshape(b, t, M_HEADS, M_HEAD_DIM).transpose(0, 2, 1, 3)
    g = gates.astype(jnp.float32).reshape(b, t, 2, 2, M_HEADS)
    logi = (g[:, :, :, 0] + ib.astype(jnp.float32)).transpose(2, 0, 3, 1)
    logf = jax.nn.log_sigmoid(g[:, :, :, 1] + fb.astype(jnp.float32)).transpose(2, 0, 3, 1)
    return heads(q) * (M_HEAD_DIM ** -0.5), heads(k), heads(v), logi, logf


def mlstm_scan(q, k, v, logi, logf, state):
    b, h, t, d = q.shape
    nc = t // M_CHUNK
    to_chunks = lambda a: jnp.moveaxis(a.astype(jnp.float32).reshape(b, h, nc, M_CHUNK, *a.shape[3:]), 2, 0)
    xs = (to_chunks(q), to_chunks(k), to_chunks(v), to_chunks(logi), to_chunks(logf))
    tri = jnp.tril(jnp.ones((M_CHUNK, M_CHUNK), bool))

    def step(carry, inp):
        C, n, m = carry
        qc, kc, vc, ic, fc = inp
        bcum = jnp.cumsum(fc, -1)
        dmat = bcum[..., :, None] - bcum[..., None, :] + ic[..., None, :]
        dmat = jnp.where(tri, dmat, -jnp.inf)
        inter = bcum + m[..., None]
        m_t = jnp.maximum(inter, dmat.max(-1))
        w = jnp.exp(dmat - m_t[..., None])
        a = jnp.exp(inter - m_t)
        s = jnp.einsum("bhtd,bhsd->bhts", qc, kc) * w
        num = a[..., None] * jnp.einsum("bhtd,bhde->bhte", qc, C) + jnp.einsum("bhts,bhse->bhte", s, vc)
        den = a * jnp.einsum("bhtd,bhd->bht", qc, n) + s.sum(-1)
        h_out = num / jnp.maximum(jnp.abs(den), jnp.exp(-m_t))[..., None]
        btot = bcum[..., -1]
        dec = btot[..., None] - bcum + ic
        m_new = jnp.maximum(btot + m, dec.max(-1))
        ws = jnp.exp(dec - m_new[..., None])
        a_st = jnp.exp(btot + m - m_new)
        C_new = a_st[..., None, None] * C + jnp.einsum("bhs,bhsd,bhse->bhde", ws, kc, vc)
        n_new = a_st[..., None] * n + jnp.einsum("bhs,bhsd->bhd", ws, kc)
        return (C_new, n_new, m_new), h_out

    state, hs = lax.scan(step, state, xs)
    return state, jnp.moveaxis(hs, 0, 2).reshape(b, h, t, d)


def mlstm_bidirectional(ctx_m, lat_m):
    qc, kc, vc, ic, fc = ctx_m
    qx, kx, vx, ix, fx = lat_m
    b = qx.shape[0]
    zero = (jnp.zeros((b, M_HEADS, M_HEAD_DIM, M_HEAD_DIM), jnp.float32),
            jnp.zeros((b, M_HEADS, M_HEAD_DIM), jnp.float32),
            jnp.zeros((b, M_HEADS), jnp.float32))
    rev = lambda a: jnp.flip(a, axis=2)
    st_f, hc_f = mlstm_scan(qc, kc, vc, ic[0], fc[0], zero)
    _, hx_f = mlstm_scan(qx, kx, vx, ix[0], fx[0], st_f)
    st_b, hc_b = mlstm_scan(rev(qc), rev(kc), rev(vc), rev(ic[1]), rev(fc[1]), zero)
    _, hx_b = mlstm_scan(rev(qx), rev(kx), rev(vx), rev(ix[1]), rev(fx[1]), st_b)
    return hx_f + rev(hx_b), hc_f + rev(hc_b)


def mlstm_output(h, o, g):
    b, _, t, _ = h.shape
    hn = h * lax.rsqrt(jnp.mean(h * h, -1, keepdims=True) + EPS)
    hn = hn.transpose(0, 2, 1, 3).reshape(b, t, M_WIDTH) * g.astype(jnp.float32)
    return hn.astype(o.dtype) * jax.nn.sigmoid(o)


def mla_project(cq, ckv, kr, qn_g, wq_up, kvn_g, wkv_up, rope):
    b, t, _ = cq.shape
    q = (rms_norm(cq, qn_g) @ wq_up).reshape(b, t, A_HEADS, A_NOPE + A_ROPE)
    kv = (rms_norm(ckv, kvn_g) @ wkv_up).reshape(b, t, A_HEADS, A_NOPE + A_V)
    q_nope, q_rope = q[..., :A_NOPE], q[..., A_NOPE:]
    k_nope, v = kv[..., :A_NOPE], kv[..., A_NOPE:]
    k_rope = kr[:, :, None, :]
    if rope is not None:
        q_rope = apply_rope(q_rope, *rope)
        k_rope = apply_rope(k_rope, *rope)
    q = jnp.concatenate([q_nope, q_rope], -1)
    k = jnp.concatenate([k_nope, jnp.broadcast_to(k_rope, (b, t, A_HEADS, A_ROPE))], -1)
    return q, k, v


def block_attention(q, k, v):
    b, tq, h, dk = q.shape
    nb = tq // Q_BLOCK
    qb = jnp.moveaxis(q.reshape(b, nb, Q_BLOCK, h, dk), 1, 0)
    scale = dk ** -0.5

    def one(qi):
        s = jnp.einsum("bqhd,bkhd->bhqk", qi, k).astype(jnp.float32) * scale
        p = jax.nn.softmax(s, -1).astype(v.dtype)
        return jnp.einsum("bhqk,bkhd->bqhd", p, v)

    out = lax.map(one, qb)
    return jnp.moveaxis(out, 0, 1).reshape(b, tq, h * v.shape[-1])


def expert_choice_moe(h, router_w, w_gate, w_up, w_down):
    b, n, _ = h.shape
    cap = EC_FACTOR * n // N_EXPERTS
    aff = jax.nn.softmax((h @ router_w).astype(jnp.float32), -1)
    g, idx = lax.top_k(jnp.swapaxes(aff, 1, 2), cap)
    xe = jax.vmap(lambda hb, ib: hb[ib])(h, idx)
    hid = jax.nn.silu(jnp.einsum("becd,edf->becf", xe, w_gate)) * jnp.einsum("becd,edf->becf", xe, w_up)
    ye = jnp.einsum("becf,efd->becd", hid, w_down) * g[..., None].astype(h.dtype)
    bidx = jnp.arange(b)[:, None, None]
    return jnp.zeros_like(h).at[bidx, idx].add(ye)


def setup_inputs(seed: int = 0) -> dict:
    key = jax.random.key(seed)
    ks = jax.random.split(key, 24)
    nrm = lambda k, shape, s: jax.random.normal(k, shape, jnp.float32) * s
    L, D = DEPTH, D_MODEL
    return {
        "x": nrm(ks[0], (BATCH, SEQ, D), 1.0),
        "c": nrm(ks[1], (BATCH, D), 1.0),
        "ctx": nrm(ks[2], (BATCH, CTX_LEN, D), 1.0),
        "c_ctx": nrm(ks[3], (D,), 1.0),
        "ada_w": nrm(ks[4], (L, D, 6 * D), 0.5 * D ** -0.5),
        "ada_b": nrm(ks[5], (L, 6 * D), 0.01),
        "norm1_g": 1.0 + nrm(ks[6], (L, D), 0.05),
        "norm2_g": 1.0 + nrm(ks[7], (L, D), 0.05),
        "w_in": nrm(ks[8], (L, D, IN_COLS), D ** -0.5),
        "m_conv_w": nrm(ks[9], (L, M_CONV_W, 2 * M_WIDTH), M_CONV_W ** -0.5),
        "m_conv_b": nrm(ks[10], (L, 2 * M_WIDTH), 0.01),
        "m_ib": nrm(ks[11], (L, 2, M_HEADS), 0.1),
        "m_fb": 3.0 + nrm(ks[12], (L, 2, M_HEADS), 0.5),
        "m_norm_g": 1.0 + nrm(ks[13], (L, M_WIDTH), 0.05),
        "a_qnorm_g": 1.0 + nrm(ks[14], (L, Q_LORA), 0.05),
        "a_wq_up": nrm(ks[15], (L, Q_LORA, A_HEADS * (A_NOPE + A_ROPE)), Q_LORA ** -0.5),
        "a_kvnorm_g": 1.0 + nrm(ks[16], (L, KV_LORA), 0.05),
        "a_wkv_up": nrm(ks[17], (L, KV_LORA, A_HEADS * (A_NOPE + A_V)), KV_LORA ** -0.5),
        "w_out": nrm(ks[18], (L, D_MIX, D), D_MIX ** -0.5),
        "router_w": nrm(ks[19], (L, D, N_EXPERTS), D ** -0.5),
        "e_w_gate": nrm(ks[20], (L, N_EXPERTS, D, EXPERT_FF), D ** -0.5),
        "e_w_up": nrm(ks[21], (L, N_EXPERTS, D, EXPERT_FF), D ** -0.5),
        "e_w_down": nrm(ks[22], (L, N_EXPERTS, EXPERT_FF, D), EXPERT_FF ** -0.5),
        "final_g": 1.0 + nrm(ks[23], (D,), 0.05),
    }


def reference(x, c, ctx, c_ctx, ada_w, ada_b, norm1_g, norm2_g, w_in, m_conv_w, m_conv_b, m_ib, m_fb,
              m_norm_g, a_qnorm_g, a_wq_up, a_kvnorm_g, a_wkv_up, w_out, router_w, e_w_gate, e_w_up,
              e_w_down, final_g):
    b, n, _ = x.shape
    rope = axial_rope(n, x.dtype)
    for layer in range(DEPTH):
        with_ctx_out = layer < DEPTH - 1
        mod_x = (jax.nn.silu(c) @ ada_w[layer] + ada_b[layer])[:, None, :]
        mod_c = (jax.nn.silu(c_ctx) @ ada_w[layer] + ada_b[layer])[None, None, :]
        sh1x, sc1x, g1x, sh2x, sc2x, g2x = jnp.split(mod_x, 6, -1)
        sh1c, sc1c, g1c, sh2c, sc2c, g2c = jnp.split(mod_c, 6, -1)

        ux = modulated_rms(x, norm1_g[layer], sh1x, sc1x) @ w_in[layer]
        uc = modulated_rms(ctx, norm1_g[layer], sh1c, sc1c) @ w_in[layer]
        fx, qkx, vx, ox, gx, cqx, ckvx, krx = split_in(ux)
        fc, qkc, vc, oc, gc, cqc, ckvc, krc = split_in(uc)

        ya_x = fourier_mix(fx)
        lat_m = mlstm_prepare(qkx, vx, gx, m_conv_w[layer], m_conv_b[layer], m_ib[layer], m_fb[layer])
        ctx_m = mlstm_prepare(qkc, vc, gc, m_conv_w[layer], m_conv_b[layer], m_ib[layer], m_fb[layer])
        hb_x, hb_c = mlstm_bidirectional(ctx_m, lat_m)
        yb_x = mlstm_output(hb_x, ox, m_norm_g[layer])
        q_x, k_x, v_x = mla_project(cqx, ckvx, krx, a_qnorm_g[layer], a_wq_up[layer], a_kvnorm_g[layer], a_wkv_up[layer], rope)
        q_c, k_c, v_c = mla_project(cqc, ckvc, krc, a_qnorm_g[layer], a_wq_up[layer], a_kvnorm_g[layer], a_wkv_up[layer], None)
        yc_x = block_attention(q_x, jnp.concatenate([k_x, k_c], 1), jnp.concatenate([v_x, v_c], 1))

        x = x + g1x * (jnp.concatenate([ya_x, yb_x, yc_x], -1) @ w_out[layer])
        if with_ctx_out:
            ya_c = fourier_mix(fc)
            yb_c = mlstm_output(hb_c, oc, m_norm_g[layer])
            yc_c = block_attention(q_c, k_c, v_c)
            ctx = ctx + g1c * (jnp.concatenate([ya_c, yb_c, yc_c], -1) @ w_out[layer])

        hx = modulated_rms(x, norm2_g[layer], sh2x, sc2x)
        x = x + g2x * expert_choice_moe(hx, router_w[layer], e_w_gate[layer], e_w_up[layer], e_w_down[layer])
        if with_ctx_out:
            hc = modulated_rms(ctx, norm2_g[layer], sh2c, sc2c)
            ctx = ctx + g2c * expert_choice_moe(hc, router_w[layer], e_w_gate[layer], e_w_up[layer], e_w_down[layer])
    return rms_norm(x, final_g)
```

```cpp
#include <hip/hip_runtime.h>
#include <cstdio>
#include <cstdint>

#define DI __device__ __forceinline__
#define LAS __attribute__((address_space(3)))
typedef unsigned short bf16_t;
typedef short bf16x8 __attribute__((ext_vector_type(8)));
typedef short s16x4 __attribute__((ext_vector_type(4)));
typedef float f32x4 __attribute__((ext_vector_type(4)));
typedef float f32x16 __attribute__((ext_vector_type(16)));
typedef float f32x2 __attribute__((ext_vector_type(2)));
typedef unsigned u32x4 __attribute__((ext_vector_type(4)));
typedef unsigned u32x2 __attribute__((ext_vector_type(2)));

constexpr int NB = 8, SEQ = 8192, CTXL = 256, TPB = SEQ + CTXL  , NROW = NB * TPB  , DM = 1024, DEPTH = 4;
constexpr int UW = 2048;
constexpr int U_F = 0, U_Q = 256, U_K = 512, U_V = 768, U_O = 1024, U_CQ = 1280, U_CKV = 1664, U_KR = 1920, U_G = 1952;
constexpr int NEXP = 16, CAPX = 1024, CAPC = 32, EROWS = NB * CAPX + NB * CAPC  , NSLOT = NEXP * EROWS  ;
constexpr int NTHR = 512;
constexpr int LDS_BYTES = 163840;
constexpr float EPS = 1e-6f;
constexpr float QSCALE = 0.10206207261596575f * 1.4426950408889634f;
constexpr int NCHUNK = TPB / 128;
constexpr int MREC = 4160;

constexpr size_t al256(size_t x) { return (x + 255) & ~(size_t)255; }
constexpr size_t WS_BAR   = 0;
constexpr size_t WS_MOD   = 16384;
constexpr size_t WS_TW    = al256(WS_MOD + (size_t)DEPTH * 9 * 6144 * 4);
constexpr size_t WS_ROPE  = al256(WS_TW + 8192 * 8);
constexpr size_t WS_WA    = al256(WS_ROPE + 192 * 8 * 8);
constexpr size_t WS_WB    = al256(WS_WA + 256 * 128 * 2);
constexpr size_t WS_WC    = al256(WS_WB + 128 * 128 * 2);
constexpr size_t WS_WIN   = al256(WS_WC + 64 * 128 * 2);
constexpr size_t WS_WQ    = al256(WS_WIN + (size_t)2048 * 1024 * 2);
constexpr size_t WS_WKV   = al256(WS_WQ + (size_t)768 * 384 * 2);
constexpr size_t WS_WOUT  = al256(WS_WKV + (size_t)1024 * 256 * 2);
constexpr size_t WS_WGU   = al256(WS_WOUT + (size_t)1024 * 1024 * 2);
constexpr size_t WS_WDN   = al256(WS_WGU + (size_t)16 * 2048 * 1024 * 2);
constexpr size_t WS_X     = al256(WS_WDN + (size_t)16 * 1024 * 1024 * 2);
constexpr size_t WS_WALT  = al256(WS_X + (size_t)NROW * 1024 * 2);
static_assert(WS_WALT + (WS_X - WS_WIN) <= WS_X + (size_t)NROW * 1024 * 4, "alternate weight set must fit behind the bf16 residual");
constexpr size_t WS_XN    = al256(WS_X + (size_t)NROW * 1024 * 4);
constexpr size_t WS_R1    = al256(WS_XN + (size_t)NROW * 1024 * 2);
constexpr size_t WS_R2    = al256(WS_R1 + (size_t)NROW * 2048 * 2);
constexpr size_t R2_Q     = 0;
constexpr size_t R2_KN    = al256(R2_Q + (size_t)NROW * 768 * 2);
constexpr size_t R2_VT    = al256(R2_KN + (size_t)NROW * 512 * 2);
constexpr size_t R2_KR    = al256(R2_VT + (size_t)NROW * 512 * 2);
constexpr size_t R2_END   = al256(R2_KR + (size_t)NROW * 32 * 2);
constexpr size_t R2_SIZE  = (size_t)NSLOT * 1024 * 2 > R2_END ? (size_t)NSLOT * 1024 * 2 : R2_END;
constexpr size_t WS_R4    = al256(WS_R2 + R2_SIZE);
constexpr size_t R4_FFTI  = 0;
constexpr size_t R4_AFF   = 0;
constexpr size_t R4_INV   = al256(R4_AFF + (size_t)NROW * 16 * 4);
constexpr size_t R4_SEL   = al256(R4_INV + (size_t)NROW * 16 * 4);
constexpr size_t R4_GATEV = al256(R4_SEL + (size_t)NSLOT * 4);
constexpr size_t R4_MST   = al256((size_t)8 * 128 * 256 * 64 * 4);
constexpr size_t R4_MSC   = al256(R4_MST + (size_t)NB * 4 * NCHUNK * 2 * MREC * 4);
constexpr size_t R4_CG    = al256(R4_MSC + (size_t)NB * 4 * NCHUNK * 2 * 16);
constexpr size_t R4_GATES = al256(R4_CG + (size_t)8 * 256 * 256 * 8);
constexpr size_t R4_SSQ   = al256(R4_GATES + (size_t)NROW * 16 * 4);
constexpr size_t R4_KMAX  = al256(R4_SSQ + (size_t)NROW * 20 * 4);
constexpr size_t R4_END   = al256(R4_KMAX + 72 * 4);
constexpr size_t WS_END   = WS_R4 + R4_END;

DI float bf2f(bf16_t b) { return __uint_as_float(((unsigned)b) << 16); }
DI bf16_t f2bf(float f) { unsigned u = __float_as_uint(f); u += 0x7FFFu + ((u >> 16) & 1u); return (bf16_t)(u >> 16); }
typedef __bf16 bf16x2_t __attribute__((ext_vector_type(2)));
DI unsigned pk2(float lo, float hi) { const f32x2 f = {lo, hi}; return __builtin_bit_cast(unsigned, __builtin_convertvector(f, bf16x2_t)); }
#ifndef X_F32
typedef bf16_t xres_t;
DI f32x4 ldx4(const xres_t* p) { const u32x2 w = *(const u32x2*)p; return (f32x4){__uint_as_float(w.x << 16), __uint_as_float(w.x & 0xffff0000u), __uint_as_float(w.y << 16), __uint_as_float(w.y & 0xffff0000u)}; }
DI void stx4(xres_t* p, f32x4 v) { u32x2 w; w.x = pk2(v[0], v[1]); w.y = pk2(v[2], v[3]); *(u32x2*)p = w; }
#else
typedef float xres_t;
DI f32x4 ldx4(const xres_t* p) { return *(const f32x4*)p; }
DI void stx4(xres_t* p, f32x4 v) { *(f32x4*)p = v; }
#endif
DI size_t wsw(size_t off, int l) { return (l & 1) ? off - WS_WIN + WS_WALT : off; }
DI f32x4 bf4(u32x2 w) { return (f32x4){__uint_as_float(w.x << 16), __uint_as_float(w.x & 0xffff0000u), __uint_as_float(w.y << 16), __uint_as_float(w.y & 0xffff0000u)}; }
DI float silu_f(float x) { return x * __builtin_amdgcn_rcpf(1.0f + __expf(-x)); }
DI float sigmoid_f(float x) { return __builtin_amdgcn_rcpf(1.0f + __expf(-x)); }
template <int CTRL> DI float dppf(float v) { return __int_as_float(__builtin_amdgcn_update_dpp(0, __float_as_int(v), CTRL, 0xF, 0xF, false)); }
DI float tsum32(float a_, float b_) { const u32x2 r = __builtin_amdgcn_permlane32_swap(__float_as_uint(a_), __float_as_uint(b_), false, false); return __uint_as_float(r.x) + __uint_as_float(r.y); }
DI float tsum16(float a_, float b_) { const u32x2 r = __builtin_amdgcn_permlane16_swap(__float_as_uint(a_), __float_as_uint(b_), false, false); return __uint_as_float(r.x) + __uint_as_float(r.y); }
DI float xor32_sum(float v) { return tsum32(v, v); }
DI float xor16_sum(float v) { return tsum16(v, v); }
DI float xor32_max(float v) { const u32x2 r = __builtin_amdgcn_permlane32_swap(__float_as_uint(v), __float_as_uint(v), false, false); return fmaxf(__uint_as_float(r.x), __uint_as_float(r.y)); }
DI float xor16_max(float v) { const u32x2 r = __builtin_amdgcn_permlane16_swap(__float_as_uint(v), __float_as_uint(v), false, false); return fmaxf(__uint_as_float(r.x), __uint_as_float(r.y)); }
DI float row_sum16(float v) { v += dppf<0xB1>(v); v += dppf<0x4E>(v); v += dppf<0x124>(v); v += dppf<0x128>(v); return v; }
DI float row_max16(float v) { v = fmaxf(v, dppf<0xB1>(v)); v = fmaxf(v, dppf<0x4E>(v)); v = fmaxf(v, dppf<0x124>(v)); v = fmaxf(v, dppf<0x128>(v)); return v; }
DI float wave_sum(float v) { return xor32_sum(xor16_sum(row_sum16(v))); }
DI float wave_max(float v) { return xor32_max(xor16_max(row_max16(v))); }
DI int tidx() { int t = threadIdx.x; asm volatile("" : "+v"(t)); return t; }
DI int bidx() { int t = blockIdx.x; asm volatile("" : "+s"(t)); return t; }
DI int gdim() { int t = gridDim.x; asm volatile("" : "+s"(t)); return t; }
DI float max3f(float a, float b, float c) { float r; asm("v_max3_f32 %0, %1, %2, %3" : "=v"(r) : "v"(a), "v"(b), "v"(c)); return r; }
#define MFMA32(a, b, c) __builtin_amdgcn_mfma_f32_32x32x16_bf16((a), (b), (c), 0, 0, 0)
DI int crow(int reg, int h) { return (reg & 3) + 8 * (reg >> 2) + 4 * h; }

#define XB_TMO      128
#define XB_XCNT(j)  (256  + 64 * (j))
#define XB_XSUB(j)  (1280 + 64 * (j))
#define XB_XGEN(j)  (2304 + 64 * (j))
#define XB_TOP      3328
#define XB_TOPGEN   3392
#define XCD_BAR_WORDS 3456
#define XB_SPIN_CAP (1u << 18)
DI unsigned xb_ld(unsigned* p)              { return __hip_atomic_load(p, __ATOMIC_RELAXED, __HIP_MEMORY_SCOPE_AGENT); }
DI unsigned xb_add(unsigned* p, unsigned v) { return __hip_atomic_fetch_add(p, v, __ATOMIC_RELAXED, __HIP_MEMORY_SCOPE_AGENT); }
DI unsigned xb_xcc_id() { return (unsigned)__builtin_amdgcn_s_getreg((3 << 11) | 20) & 0xFu; }
#define XB_SPIN(cond, bar) do { unsigned _sp = 0; while (cond) { __builtin_amdgcn_s_sleep(1); \
    if ((++_sp & 255u) == 0u) { if (xb_ld(&(bar)[XB_TMO])) break; if (_sp > XB_SPIN_CAP) { atomicAdd(&(bar)[XB_TMO], 1u); break; } } } } while (0)
struct XcdBarrier { unsigned* bar; unsigned x; volatile LAS unsigned* st; };
DI XcdBarrier xcd_barrier_post(unsigned* bar, volatile LAS unsigned* st) {
    XcdBarrier b; b.bar = bar; b.x = xb_xcc_id(); b.st = st;
    if (threadIdx.x == 0) (void)xb_add(&bar[XB_XCNT(b.x)], 1u);
    return b;
}
DI void xcd_barrier_complete(unsigned* bar, unsigned x, unsigned& nloc, unsigned& nx) {
    const unsigned G = gridDim.x * gridDim.y * gridDim.z;
    unsigned sum, cnt, mine, sp = 0u;
    for (;;) {
        sum = 0u; cnt = 0u; mine = 0u;
#pragma unroll
        for (unsigned j = 0; j < 16; ++j) { const unsigned c = xb_ld(&bar[XB_XCNT(j)]); sum += c; cnt += (c > 0u) ? 1u : 0u; mine = (j == x) ? c : mine; }
        if (sum == G) break;
        __builtin_amdgcn_s_sleep(1);
        if ((++sp & 255u) == 0u) { if (xb_ld(&bar[XB_TMO])) break; if (sp > XB_SPIN_CAP) { atomicAdd(&bar[XB_TMO], 1u); break; } }
    }
    nloc = mine > 0u ? mine : 1u; nx = cnt > 0u ? cnt : 1u;
}
DI void xcd_barrier(const XcdBarrier& b) {
    asm volatile("s_waitcnt vmcnt(0)" ::: "memory");
    __syncthreads();
    if (threadIdx.x == 0) {
        unsigned* bar = b.bar;
        __builtin_amdgcn_s_waitcnt(0);
        unsigned nloc = b.st[0], nx = b.st[1];
        if (nloc == 0u) { xcd_barrier_complete(bar, b.x, nloc, nx); b.st[0] = nloc; b.st[1] = nx; }
        const unsigned old = xb_add(&bar[XB_XSUB(b.x)], 1u);
        const unsigned gen = old / nloc;
        if (old + 1u == (gen + 1u) * nloc) {
            __builtin_amdgcn_fence(__ATOMIC_RELEASE, "agent");
            asm volatile("s_waitcnt vmcnt(0)" ::: "memory");
            const unsigned og = xb_add(&bar[XB_TOP], 1u);
            const unsigned tg = og / nx;
            if (og + 1u == (tg + 1u) * nx) xb_add(&bar[XB_TOPGEN], 1u);
            else XB_SPIN(xb_ld(&bar[XB_TOPGEN]) == tg, bar);
            __builtin_amdgcn_fence(__ATOMIC_ACQUIRE, "agent");
            xb_add(&bar[XB_XGEN(b.x)], 1u);
            asm volatile("s_waitcnt vmcnt(0)" ::: "memory");
        } else {
            XB_SPIN(xb_ld(&bar[XB_XGEN(b.x)]) == gen, bar);
            __builtin_amdgcn_fence(__ATOMIC_ACQUIRE, "agent");
            asm volatile("s_waitcnt vmcnt(0)" ::: "memory");
        }
    }
    __syncthreads();
}

struct Args {
    const float* x; const float* c; const float* ctx; const float* c_ctx; const float* ada_w; const float* ada_b; const float* norm1_g; const float* norm2_g;
    const float* w_in; const float* m_conv_w; const float* m_conv_b; const float* m_ib; const float* m_fb; const float* m_norm_g; const float* a_qnorm_g; const float* a_wq_up;
    const float* a_kvnorm_g; const float* a_wkv_up; const float* w_out; const float* router_w; const float* e_w_gate; const float* e_w_up; const float* e_w_down; const float* final_g;
    float* out; unsigned char* ws; int ph_lo, ph_hi;
};
#define MK_SINGLE 1
namespace pg8 {
constexpr int BM = 256, BK = 64, HALF = 128, HTB = HALF * BK * 2  , STAGE_BYTES = 8 * HTB, NXCD = 8, WGM = 8;
__host__ __device__ __forceinline__ int lds_byte(int r, int c) { const int st = (r >> 4) * 2 + (c >> 5), rr = r & 15, cc = c & 31, ob = rr * 64 + cc * 2; return st * 1024 + (ob ^ (((ob >> 9) & 1) << 5)); }
__host__ __device__ __forceinline__ void stage_rc(int b, int& R, int& C) { const int st = b / 1024, sb = b % 1024, swz = sb ^ (((sb >> 9) & 1) << 5); R = (st >> 1) * 16 + swz / 64; C = (st & 1) * 32 + (swz % 64) / 2; }
__host__ __device__ __forceinline__ int perm32(int rho) { const int n = rho >> 4, i = rho & 15; return 8 * (i >> 2) + 4 * n + (i & 3); }

struct Unit { int pm, pn; };
struct Gemm { const bf16_t* A; const bf16_t* Bt; int M, N, K, lda, ldb, grp_units; size_t grp_stride; const int* rowidx; int skip; };

struct StaticOrder {
    int nM, nN, nwg, G, c;
    __device__ void init(int M, int N, int G_, int c_) { nM = M / BM; nN = N / BM; nwg = nM * nN; G = G_; c = c_; }
    __device__ bool next(int i, Unit& u) const {
        const long L = (long)i * G + c; if (L >= nwg) return false;
        int wgid = (int)L; { const int q = nwg / NXCD, r = nwg % NXCD, xcd = wgid % NXCD, off = wgid / NXCD; wgid = (xcd < r ? xcd * (q + 1) : r * (q + 1) + (xcd - r) * q) + off; }
        const int nig = WGM * nN, gid = wgid / nig, fm = gid * WGM, gsz = (nM - fm) < WGM ? (nM - fm) : WGM;
        u.pm = fm + ((wgid % nig) % gsz); u.pn = (wgid % nig) / gsz; return true;
    }
};

template <class Epi>
__device__ __forceinline__ void gemm_phase(LAS unsigned char* lds, const Gemm g, const StaticOrder& S, const Epi& E) {
    const int tid = tidx(), wid = __builtin_amdgcn_readfirstlane(tid >> 6), lane = tid & 63, wr = wid >> 2, wc = wid & 3, fr = lane & 15, fq = lane >> 4;
    const int K = g.K, nt = K / BK;
    unsigned voffB[2]; int RA[2], CA[2];
#pragma unroll
    for (int i = 0; i < 2; ++i) { int R, C; stage_rc(tid * 16 + i * 8192, R, C); const int Rb = Epi::PERM ? ((R & ~31) + perm32(R & 31)) : R;
        RA[i] = R; CA[i] = C; voffB[i] = (unsigned)(Rb * g.ldb + C) * 2u; }
#define PG8_AOFF(dst, pm_) do { _Pragma("unroll") for (int h_ = 0; h_ < 2; ++h_) _Pragma("unroll") for (int i_ = 0; i_ < 2; ++i_) { \
        const int r_ = (pm_) * BM + h_ * HALF + RA[i_]; const int rr_ = g.rowidx ? g.rowidx[r_] : r_; \
        dst[h_][i_] = (unsigned)rr_ * (unsigned)(g.lda * 2) + (unsigned)(CA[i_] * 2); } } while (0)
    const size_t kstep = (size_t)(BK * 2);
    const size_t hstepB = (size_t)HALF * g.ldb * 2;
    const size_t tstepB = 2 * hstepB;
    const unsigned ldsw = (unsigned)wid * 1024u;
    const int aoff = lds_byte(wr * 64 + fr, fq * 8), boff = lds_byte(wc * 32 + fr, fq * 8);
#define PG8_SA(b, h) (((b) * 2 + (h)) * HTB)
#define PG8_SB(b, h) ((4 + (b) * 2 + (h)) * HTB)
#define PG8_STAGE(bufoff, gbase, voff) do { _Pragma("unroll") for (int _i = 0; _i < 2; ++_i) \
        __builtin_amdgcn_global_load_lds((const unsigned*)((const char*)(gbase) + (voff)[_i]), (LAS unsigned*)(lds + (bufoff) + ldsw + _i * 8192), 16, 0, 0); } while (0)
#define PG8_LDA(dst, b, h) do { _Pragma("unroll") for (int m = 0; m < 4; ++m) _Pragma("unroll") for (int k = 0; k < 2; ++k) dst[m][k] = *(const LAS bf16x8*)(lds + PG8_SA(b, h) + aoff + m * 2048 + k * 1024); } while (0)
#define PG8_LDB(dst, b, h) do { _Pragma("unroll") for (int n = 0; n < 2; ++n) _Pragma("unroll") for (int k = 0; k < 2; ++k) dst[n][k] = *(const LAS bf16x8*)(lds + PG8_SB(b, h) + boff + n * 2048 + k * 1024); } while (0)
#define PG8_MMA(ai, bj, At, Bt) do { __builtin_amdgcn_s_setprio(1); _Pragma("unroll") for (int m = 0; m < 4; ++m) _Pragma("unroll") for (int n = 0; n < 2; ++n) _Pragma("unroll") for (int k = 0; k < 2; ++k) \
        acc[ai][bj][m][n] = __builtin_amdgcn_mfma_f32_16x16x32_bf16(Bt[n][k], At[m][k], acc[ai][bj][m][n], 0, 0, 0); __builtin_amdgcn_s_setprio(0); } while (0)
#define PG8_WAIT_V(n) asm volatile("s_waitcnt vmcnt(" #n ")" ::: "memory")
#define PG8_WAIT_L(n) asm volatile("s_waitcnt lgkmcnt(" #n ")" ::: "memory")
#define PG8_BAR __builtin_amdgcn_s_barrier()
#define PG8_SCHED __builtin_amdgcn_sched_barrier(0)
    Unit cur, nxt; int ui = 0;
    if (!S.next(0, cur)) return;
    if (g.skip) cur.pm = cur.pm + cur.pm / 32 + (g.skip == 1 ? 1 : 0);
    f32x4 acc[2][2][4][2];
#pragma unroll
    for (int a = 0; a < 2; ++a)
#pragma unroll
        for (int b = 0; b < 2; ++b)
#pragma unroll
            for (int m = 0; m < 4; ++m)
#pragma unroll
                for (int n = 0; n < 2; ++n) acc[a][b][m][n] = (f32x4){0.f, 0.f, 0.f, 0.f};
    bf16x8 At[4][2], B0[2][2], B1[2][2];
    unsigned curA[2][2], nxtA[2][2];
    PG8_AOFF(curA, cur.pm);
    const char* gA = (const char*)g.A;
    const char* cB = (const char*)g.Bt + ((size_t)(cur.pm / g.grp_units) * g.grp_stride) * 2 + (size_t)cur.pn * tstepB;
    PG8_STAGE(PG8_SB(0, 0), cB, voffB); PG8_STAGE(PG8_SA(0, 0), gA, curA[0]); PG8_STAGE(PG8_SB(0, 1), cB + hstepB, voffB); PG8_STAGE(PG8_SA(0, 1), gA, curA[1]);
    if (wr == 1) PG8_BAR;
    PG8_WAIT_V(4); PG8_BAR;
    PG8_STAGE(PG8_SB(1, 0), cB + kstep, voffB); PG8_STAGE(PG8_SA(1, 0), gA + kstep, curA[0]); PG8_STAGE(PG8_SB(1, 1), cB + hstepB + kstep, voffB);
    PG8_WAIT_V(6); PG8_BAR;
    for (;;) {
        const bool has_next = S.next(ui + 1, nxt);
        if (has_next && g.skip) nxt.pm = nxt.pm + nxt.pm / 32 + (g.skip == 1 ? 1 : 0);
        if (has_next) PG8_AOFF(nxtA, nxt.pm);
        else { _Pragma("unroll") for (int h_ = 0; h_ < 2; ++h_) _Pragma("unroll") for (int i_ = 0; i_ < 2; ++i_) nxtA[h_][i_] = curA[h_][i_]; }
        const char* nB = has_next ? (const char*)g.Bt + ((size_t)(nxt.pm / g.grp_units) * g.grp_stride) * 2 + (size_t)nxt.pn * tstepB : cB;
#pragma nounroll
        for (int t = 0; t < nt; t += 2) {
            const bool last = (t == nt - 2);
            const char* a1 = gA + (size_t)(t + 1) * kstep;
            const char* a2 = last ? gA : gA + (size_t)(t + 2) * kstep; const char* b2 = last ? nB : cB + (size_t)(t + 2) * kstep;
            const char* a3 = a2 + kstep; const char* b3 = b2 + kstep;
            unsigned oA0[2], oA1[2];
            oA0[0] = last ? nxtA[0][0] : curA[0][0]; oA0[1] = last ? nxtA[0][1] : curA[0][1]; oA1[0] = last ? nxtA[1][0] : curA[1][0]; oA1[1] = last ? nxtA[1][1] : curA[1][1];
            PG8_LDB(B0, 0, 0); PG8_SCHED; PG8_LDA(At, 0, 0); PG8_STAGE(PG8_SA(1, 1), a1, curA[1]);
            PG8_WAIT_L(8); PG8_BAR; PG8_WAIT_L(0); PG8_MMA(0, 0, At, B0); PG8_BAR; PG8_SCHED;
            PG8_LDB(B1, 0, 1); PG8_STAGE(PG8_SB(0, 0), b2, voffB);
            PG8_BAR; PG8_WAIT_L(0); PG8_MMA(0, 1, At, B1); PG8_BAR;
            PG8_LDA(At, 0, 1); PG8_STAGE(PG8_SA(0, 0), a2, oA0);
            PG8_BAR; PG8_WAIT_L(0); PG8_MMA(1, 0, At, B0); PG8_BAR; PG8_SCHED;
            PG8_STAGE(PG8_SB(0, 1), b2 + hstepB, voffB);
            PG8_WAIT_V(6); PG8_BAR; PG8_MMA(1, 1, At, B1); PG8_BAR;
            PG8_LDB(B0, 1, 0); PG8_SCHED; PG8_LDA(At, 1, 0); PG8_STAGE(PG8_SA(0, 1), a2, oA1);
            PG8_WAIT_L(8); PG8_BAR; PG8_WAIT_L(0); PG8_MMA(0, 0, At, B0); PG8_BAR; PG8_SCHED;
            PG8_LDB(B1, 1, 1); PG8_STAGE(PG8_SB(1, 0), b3, voffB);
            PG8_BAR; PG8_WAIT_L(0); PG8_MMA(0, 1, At, B1); PG8_BAR;
            PG8_LDA(At, 1, 1); PG8_STAGE(PG8_SA(1, 0), a3, oA0);
            PG8_BAR; PG8_WAIT_L(0); PG8_MMA(1, 0, At, B0); PG8_BAR; PG8_SCHED;
            PG8_STAGE(PG8_SB(1, 1), b3 + hstepB, voffB);
            PG8_WAIT_V(6); PG8_BAR; PG8_MMA(1, 1, At, B1); PG8_BAR;
        }
        E(acc, cur, wr, wc, fr, fq);
        if (!has_next) break;
#pragma unroll
        for (int a = 0; a < 2; ++a)
#pragma unroll
            for (int b = 0; b < 2; ++b)
#pragma unroll
                for (int m = 0; m < 4; ++m)
#pragma unroll
                    for (int n = 0; n < 2; ++n) acc[a][b][m][n] = (f32x4){0.f, 0.f, 0.f, 0.f};
        cur = nxt; cB = nB; ++ui;
#pragma unroll
        for (int h_ = 0; h_ < 2; ++h_)
#pragma unroll
            for (int i_ = 0; i_ < 2; ++i_) curA[h_][i_] = nxtA[h_][i_];
    }
    PG8_WAIT_V(0);
    if (wr == 0) PG8_BAR;
    PG8_BAR;
#undef PG8_AOFF
#undef PG8_SA
#undef PG8_SB
#undef PG8_STAGE
#undef PG8_LDA
#undef PG8_LDB
#undef PG8_MMA
#undef PG8_WAIT_V
#undef PG8_WAIT_L
#undef PG8_BAR
#undef PG8_SCHED
}
}
using pg8::Unit;
typedef f32x4 AccT[2][2][4][2];

struct EpiIn {
    static constexpr bool PERM = true;
    bf16_t* U; float* gates; float* ssq;
    DI void operator()(const AccT& acc, const Unit& u, int wr, int wc, int fr, int fq) const {
        const int row0 = u.pm * 256 + wr * 64 + fr, col0 = u.pn * 256 + wc * 32 + 8 * fq;
#pragma unroll
        for (int ai = 0; ai < 2; ++ai)
#pragma unroll
            for (int m = 0; m < 4; ++m) {
                const int row = row0 + ai * 128 + m * 16;
#pragma unroll
                for (int bj = 0; bj < 2; ++bj) {
                    const f32x4 v0 = acc[ai][bj][m][0], v1 = acc[ai][bj][m][1];
                    u32x4 w; w.x = pk2(v0[0], v0[1]); w.y = pk2(v0[2], v0[3]); w.z = pk2(v1[0], v1[1]); w.w = pk2(v1[2], v1[3]);
                    *(u32x4*)(U + (size_t)row * UW + col0 + bj * 128) = w;
                    int slot = -1;
                    if (u.pn == 5) slot = bj * 4 + wc; else if (u.pn == 6) slot = (bj == 0 ? 8 : 12) + wc; else if (u.pn == 7 && bj == 0) slot = 16 + wc;
                    if (slot >= 0) {
                        float s = v0[0] * v0[0] + v0[1] * v0[1] + v0[2] * v0[2] + v0[3] * v0[3] + v1[0] * v1[0] + v1[1] * v1[1] + v1[2] * v1[2] + v1[3] * v1[3];
                        s = xor32_sum(xor16_sum(s));
                        if (fq == 0) ssq[(size_t)row * 20 + slot] = s;
                    }
                }
                if (u.pn == 7 && wc == 1 && fq < 2) {
                    *(f32x4*)(gates + (size_t)row * 16 + 8 * fq) = acc[ai][1][m][0];
                    *(f32x4*)(gates + (size_t)row * 16 + 8 * fq + 4) = acc[ai][1][m][1];
                }
            }
    }
};

struct EpiQ {
    static constexpr bool PERM = true;
    bf16_t* Q; const float* ssq;
    DI void operator()(const AccT& acc, const Unit& u, int wr, int wc, int fr, int fq) const {
        float rstds[2][4];
#pragma unroll
        for (int ai = 0; ai < 2; ++ai) {
            f32x4 sp[4][3];
#pragma unroll
            for (int m = 0; m < 4; ++m) { const f32x4* p = (const f32x4*)(ssq + (size_t)(u.pm * 256 + wr * 64 + fr + ai * 128 + m * 16) * 20); sp[m][0] = p[0]; sp[m][1] = p[1]; sp[m][2] = p[2]; }
#pragma unroll
            for (int m = 0; m < 4; ++m) { const f32x4 s0 = sp[m][0], s1 = sp[m][1], s2 = sp[m][2];
                const float sq = ((s0[0] + s0[1]) + (s0[2] + s0[3])) + ((s1[0] + s1[1]) + (s1[2] + s1[3])) + ((s2[0] + s2[1]) + (s2[2] + s2[3]));
                rstds[ai][m] = rsqrtf(sq * (1.0f / 384.0f) + EPS) * QSCALE; }
            asm volatile("" ::: "memory");
        }
#pragma unroll
        for (int ai = 0; ai < 2; ++ai)
#pragma unroll
            for (int m = 0; m < 4; ++m) {
                const int row = u.pm * 256 + wr * 64 + fr + ai * 128 + m * 16;
                const float rstd = rstds[ai][m];
#pragma unroll
                for (int bj = 0; bj < 2; ++bj) {
                    const f32x4 v0 = acc[ai][bj][m][0] * rstd, v1 = acc[ai][bj][m][1] * rstd;
                    u32x4 w; w.x = pk2(v0[0], v0[1]); w.y = pk2(v0[2], v0[3]); w.z = pk2(v1[0], v1[1]); w.w = pk2(v1[2], v1[3]);
                    *(u32x4*)(Q + (size_t)row * 768 + u.pn * 256 + bj * 128 + wc * 32 + 8 * fq) = w;
                }
                asm volatile("" ::: "memory");
            }
    }
};

struct EpiKV {
    static constexpr bool PERM = true;
    bf16_t* KN; bf16_t* VT; const float* ssq;
    DI void operator()(const AccT& acc, const Unit& u, int wr, int wc, int fr, int fq) const {
        const int b = u.pm / 33, posb = (u.pm % 33) * 256;
        float rstds[2][4];
        {
#pragma unroll
            for (int ai = 0; ai < 2; ++ai) {
                f32x4 sp[4][2];
#pragma unroll
                for (int m = 0; m < 4; ++m) { const f32x4* p = (const f32x4*)(ssq + (size_t)(u.pm * 256 + wr * 64 + fr + ai * 128 + m * 16) * 20 + 12); sp[m][0] = p[0]; sp[m][1] = p[1]; }
#pragma unroll
                for (int m = 0; m < 4; ++m) { const f32x4 s0 = sp[m][0], s1 = sp[m][1];
                    const float sq = ((s0[0] + s0[1]) + (s0[2] + s0[3])) + ((s1[0] + s1[1]) + (s1[2] + s1[3]));
                    rstds[ai][m] = rsqrtf(sq * (1.0f / 256.0f) + EPS); }
                asm volatile("" ::: "memory");
            }
        }
#pragma unroll
        for (int ai = 0; ai < 2; ++ai)
#pragma unroll
            for (int m = 0; m < 4; ++m) {
                const int rl = wr * 64 + fr + ai * 128 + m * 16, row = u.pm * 256 + rl, pos = posb + rl;
                const float rstd = rstds[ai][m];
#pragma unroll
                for (int bj = 0; bj < 2; ++bj) {
                    const int head = 2 * u.pn + bj;
                    float v[8];
#pragma unroll
                    for (int j = 0; j < 4; ++j) { v[j] = acc[ai][bj][m][0][j] * rstd; v[4 + j] = acc[ai][bj][m][1][j] * rstd; }
                    if (wc < 2) {
                        u32x4 w; w.x = pk2(v[0], v[1]); w.y = pk2(v[2], v[3]); w.z = pk2(v[4], v[5]); w.w = pk2(v[6], v[7]);
                        *(u32x4*)(KN + (size_t)row * 512 + head * 64 + wc * 32 + 8 * fq) = w;
                    } else {
                        const int e0 = (wc - 2) * 32 + 8 * fq;
                        bf16_t* dst = VT + ((size_t)(b * 8 + head) * 64 + e0) * TPB + pos;
#pragma unroll
                        for (int j = 0; j < 8; ++j) dst[(size_t)j * TPB] = f2bf(v[j]);
                    }
                }
                asm volatile("" ::: "memory");
            }
    }
};

struct EpiOut {
    static constexpr bool PERM = false;
    xres_t* X; const float* mod; float scale;
    DI void operator()(const AccT& acc, const Unit& u, int wr, int wc, int fr, int fq) const {
        const int b = u.pm / 33, mrow = (u.pm % 33 == 0) ? 8 : b;
        const float* g1 = mod + (size_t)mrow * 6144 + 2048;
        xres_t* xbase = X + (size_t)u.pm * 256 * 1024;
        f32x4 gv[2][2];
#pragma unroll
        for (int bj = 0; bj < 2; ++bj)
#pragma unroll
            for (int n = 0; n < 2; ++n) gv[bj][n] = *(const f32x4*)(g1 + u.pn * 256 + bj * 128 + wc * 32 + 16 * n + 4 * fq) * scale;
#pragma unroll
        for (int ai = 0; ai < 2; ++ai)
#pragma unroll
            for (int mp = 0; mp < 2; ++mp) {
                f32x4 xv[2][2][2];
#pragma unroll
                for (int mm = 0; mm < 2; ++mm) {
                    const size_t ro = (size_t)(wr * 64 + fr + ai * 128 + (2 * mp + mm) * 16) * 1024;
#pragma unroll
                    for (int bj = 0; bj < 2; ++bj)
#pragma unroll
                        for (int n = 0; n < 2; ++n) xv[mm][bj][n] = ldx4(xbase + ro + u.pn * 256 + bj * 128 + wc * 32 + 16 * n + 4 * fq);
                }
#pragma unroll
                for (int mm = 0; mm < 2; ++mm) {
                    const size_t ro = (size_t)(wr * 64 + fr + ai * 128 + (2 * mp + mm) * 16) * 1024;
#pragma unroll
                    for (int bj = 0; bj < 2; ++bj)
#pragma unroll
                        for (int n = 0; n < 2; ++n) stx4(xbase + ro + u.pn * 256 + bj * 128 + wc * 32 + 16 * n + 4 * fq, xv[mm][bj][n] + gv[bj][n] * acc[ai][bj][2 * mp + mm][n]);
                }
            }
    }
};

struct EpiGU {
    static constexpr bool PERM = true;
    bf16_t* H;
    DI void operator()(const AccT& acc, const Unit& u, int wr, int wc, int fr, int fq) const {
#pragma unroll
        for (int ai = 0; ai < 2; ++ai)
#pragma unroll
            for (int m = 0; m < 4; ++m) {
                const int row = u.pm * 256 + wr * 64 + fr + ai * 128 + m * 16;
                float v[8];
#pragma unroll
                for (int j = 0; j < 4; ++j) { v[j] = silu_f(acc[ai][0][m][0][j]) * acc[ai][1][m][0][j]; v[4 + j] = silu_f(acc[ai][0][m][1][j]) * acc[ai][1][m][1][j]; }
                u32x4 w; w.x = pk2(v[0], v[1]); w.y = pk2(v[2], v[3]); w.z = pk2(v[4], v[5]); w.w = pk2(v[6], v[7]);
                *(u32x4*)(H + (size_t)row * 1024 + u.pn * 128 + wc * 32 + 8 * fq) = w;
            }
    }
};

struct EpiDN {
    static constexpr bool PERM = true;
    bf16_t* Y; const float* gatev;
    DI void operator()(const AccT& acc, const Unit& u, int wr, int wc, int fr, int fq) const {
        float gvs[2][4];
#pragma unroll
        for (int ai = 0; ai < 2; ++ai)
#pragma unroll
            for (int m = 0; m < 4; ++m) gvs[ai][m] = gatev[u.pm * 256 + wr * 64 + fr + ai * 128 + m * 16];
#pragma unroll
        for (int ai = 0; ai < 2; ++ai)
#pragma unroll
            for (int m = 0; m < 4; ++m) {
                const int row = u.pm * 256 + wr * 64 + fr + ai * 128 + m * 16;
                const float gv = gvs[ai][m];
#pragma unroll
                for (int bj = 0; bj < 2; ++bj) {
                    const f32x4 v0 = acc[ai][bj][m][0] * gv, v1 = acc[ai][bj][m][1] * gv;
                    u32x4 w; w.x = pk2(v0[0], v0[1]); w.y = pk2(v0[2], v0[3]); w.z = pk2(v1[0], v1[1]); w.w = pk2(v1[2], v1[3]);
                    *(u32x4*)(Y + (size_t)row * 1024 + u.pn * 256 + bj * 128 + wc * 32 + 8 * fq) = w;
                }
            }
    }
};
DI int ropeperm(int p) { return (p & 1) ? 16 + (p >> 1) : (p >> 1); }

DI void phase_prologue(const Args& a, LAS unsigned char* lds) {
    const int tid = tidx();
    LAS float* sc = (LAS float*)lds;
    LAS float* red = (LAS float*)(lds + 9 * 1024 * 4);
    for (int i = tid; i < 9 * 1024; i += NTHR) { const float v = (i < 8192) ? a.c[i] : a.c_ctx[i - 8192]; sc[i] = silu_f(v); }
    __syncthreads();
    float* MOD = (float*)(a.ws + WS_MOD);
    for (int un = bidx(); un < DEPTH * 48; un += gdim()) {
        const int l = un / 48, cb = (un % 48) * 128, col = tid & 127, kq = tid >> 7;
        const float* w = a.ada_w + (size_t)l * 1024 * 6144 + cb + col;
        float acc[9];
#pragma unroll
        for (int r = 0; r < 9; ++r) acc[r] = 0.f;
        for (int k0 = kq * 256; k0 < kq * 256 + 256; k0 += 16) {
            float wv[16];
#pragma unroll
            for (int i = 0; i < 16; ++i) wv[i] = w[(size_t)(k0 + i) * 6144];
#pragma unroll
            for (int i = 0; i < 16; ++i)
#pragma unroll
                for (int r = 0; r < 9; ++r) acc[r] += sc[r * 1024 + k0 + i] * wv[i];
        }
#pragma unroll
        for (int r = 0; r < 9; ++r) red[(kq * 9 + r) * 128 + col] = acc[r];
        __syncthreads();
        for (int i = tid; i < 9 * 128; i += NTHR) {
            const int r = i / 128, cc = i % 128;
            const float s = red[(0 * 9 + r) * 128 + cc] + red[(1 * 9 + r) * 128 + cc] + red[(2 * 9 + r) * 128 + cc] + red[(3 * 9 + r) * 128 + cc];
            MOD[((size_t)l * 9 + r) * 6144 + cb + cc] = s + a.ada_b[(size_t)l * 6144 + cb + cc];
        }
        __syncthreads();
    }
    const int gt = bidx() * NTHR + tid, gn = gdim() * NTHR;
    f32x2* TW = (f32x2*)(a.ws + WS_TW);
    for (int i = gt; i < 8192; i += gn) { float s, c; sincospif((float)i * (1.0f / 4096.0f), &s, &c); TW[i] = (f32x2){c, s}; }
    f32x2* RP = (f32x2*)(a.ws + WS_ROPE);
    for (int i = gt; i < 192 * 8; i += gn) {
        const int id = (i < 1024) ? (i >> 3) : ((i - 1024) >> 3), f = i & 7;
        const float inv = powf(10000.0f, -(float)f / 8.0f), ang = (float)id * inv;
        RP[i] = (f32x2){cosf(ang), sinf(ang)};
    }
    bf16_t* WA = (bf16_t*)(a.ws + WS_WA);
    for (int i = gt; i < 256 * 128; i += gn) {
        const int m = i >> 7, t1 = i & 127, k1 = m & 127, ri = m >> 7;
        float s, c; sincospif((float)((k1 * t1) & 127) * (1.0f / 64.0f), &s, &c);
        WA[i] = f2bf(ri ? -s : c);
    }
    bf16_t* WB = (bf16_t*)(a.ws + WS_WB);
    for (int i = gt; i < 128 * 128; i += gn) {
        const int m = i >> 7, kk = i & 127, k2 = m & 63, ro = m >> 6, t2 = kk >> 1, ri = kk & 1;
        float s, c; sincospif((float)((k2 * t2) & 63) * (1.0f / 32.0f), &s, &c);
        WB[i] = f2bf(ro == 0 ? (ri == 0 ? c : s) : (ri == 0 ? -s : c));
    }
    bf16_t* WC = (bf16_t*)(a.ws + WS_WC);
    for (int i = gt; i < 64 * 128; i += gn) {
        const int l = i >> 7, kk = i & 127, cch = kk & 63, ri = kk >> 6;
        float s, c; sincospif((float)((l * cch) & 63) * (1.0f / 32.0f), &s, &c);
        WC[i] = f2bf(ri ? s : c);
    }
}

constexpr int WPREP_TILES = 32 * 16 + 12 * 6 + 16 * 4 + 16 * 16 + 16 * 32 * 16 + 16 * 16 * 16;
DI void phase_wprep(const Args& a, int l, LAS unsigned char* lds, int t0 = 0, int t1 = WPREP_TILES, int vb = -1, int nvb = 0) {
    if (vb < 0) { vb = bidx(); nvb = gdim(); }
    const int tid = tidx();
    LAS float* tile = (LAS float*)lds;
    constexpr int T_IN = 32 * 16, T_Q = 12 * 6, T_KV = 16 * 4, T_OUT = 16 * 16, T_GU = 16 * 32 * 16, T_DN = 16 * 16 * 16;
    constexpr int O_Q = T_IN, O_KV = O_Q + T_Q, O_OUT = O_KV + T_KV, O_GU = O_OUT + T_OUT, O_DN = O_GU + T_GU, T_ALL = O_DN + T_DN;
    const int grp = tid >> 7, tl = tid & 127;
    LAS float* mytile = tile + grp * (64 * 65);
    static_assert(T_ALL == WPREP_TILES, "tile count");
    __syncthreads();
    for (int base = t0 + vb * 4; base < t1; base += nvb * 4) {
        const int tix = base + grp; const bool valid = tix < t1;
        int kind = 0, e = 0, nt = 0, kt = 0, K = 1024, ldsrc = 1024; bf16_t* dst = nullptr; const float* src = nullptr; const float* kscale = nullptr;
        if (valid) {
            if (tix < O_Q)        { kind = 0; const int t = tix;          nt = t / 16; kt = t % 16; K = 1024; ldsrc = 1968; src = a.w_in + (size_t)l * 1024 * 1968; dst = (bf16_t*)(a.ws + wsw(WS_WIN, l)); }
            else if (tix < O_KV)  { kind = 1; const int t = tix - O_Q;    nt = t / 6;  kt = t % 6;  K = 384;  ldsrc = 768;  src = a.a_wq_up + (size_t)l * 384 * 768; dst = (bf16_t*)(a.ws + wsw(WS_WQ, l)); kscale = a.a_qnorm_g + l * 384; }
            else if (tix < O_OUT) { kind = 2; const int t = tix - O_KV;   nt = t / 4;  kt = t % 4;  K = 256;  ldsrc = 1024; src = a.a_wkv_up + (size_t)l * 256 * 1024; dst = (bf16_t*)(a.ws + wsw(WS_WKV, l)); kscale = a.a_kvnorm_g + l * 256; }
            else if (tix < O_GU)  { kind = 3; const int t = tix - O_OUT;  nt = t / 16; kt = t % 16; K = 1024; ldsrc = 1024; src = a.w_out + (size_t)l * 1024 * 1024; dst = (bf16_t*)(a.ws + wsw(WS_WOUT, l)); }
            else if (tix < O_DN)  { kind = 4; const int t = tix - O_GU;   e = t / 512; nt = (t % 512) / 16; kt = t % 16; K = 1024; ldsrc = 1024; src = nullptr; dst = (bf16_t*)(a.ws + wsw(WS_WGU, l)) + (size_t)e * 2048 * 1024; }
            else                  { kind = 5; const int t = tix - O_DN;   e = t / 256; nt = (t % 256) / 16; kt = t % 16; K = 1024; ldsrc = 1024; src = a.e_w_down + ((size_t)l * 16 + e) * 1024 * 1024; dst = (bf16_t*)(a.ws + wsw(WS_WDN, l)) + (size_t)e * 1024 * 1024; }
            const int nl = tl & 63, n = nt * 64 + nl;
            int col = n; const float* s2 = src;
            if (kind == 0) { if (n < 1280) col = n; else if (n < 1920) col = n + 16; else if (n < 1952) col = 1936 + ropeperm(n - 1920); else if (n < 1968) col = 1280 + (n - 1952); else col = -1; }
            else if (kind == 1) { const int h = n / 96, j = n % 96; col = (j < 64) ? n : h * 96 + 64 + ropeperm(j - 64); }
            else if (kind == 4) { const int pn = n >> 8, bj = (n >> 7) & 1, j = n & 127; col = pn * 128 + j; s2 = (bj ? a.e_w_up : a.e_w_gate) + ((size_t)l * 16 + e) * 1024 * 1024; }
            float v[32];
#pragma unroll
            for (int i = 0; i < 32; ++i) {
                const int kl = (tl >> 6) + 2 * i, k = kt * 64 + kl;
                v[i] = (col >= 0) ? s2[(size_t)k * ldsrc + col] : 0.f;
            }
            if (kscale) {
#pragma unroll
                for (int i = 0; i < 32; ++i) v[i] *= kscale[kt * 64 + (tl >> 6) + 2 * i];
            }
#pragma unroll
            for (int i = 0; i < 32; ++i) mytile[nl * 65 + (tl >> 6) + 2 * i] = v[i];
        }
        __syncthreads();
        if (valid) {
#pragma unroll
            for (int q = 0; q < 4; ++q) {
                const int ch = tl + 128 * q, nl2 = ch >> 3, kc = (ch & 7) * 8;
                const LAS float* tp = mytile + nl2 * 65 + kc;
                u32x4 w; w.x = pk2(tp[0], tp[1]); w.y = pk2(tp[2], tp[3]); w.z = pk2(tp[4], tp[5]); w.w = pk2(tp[6], tp[7]);
                *(u32x4*)(dst + (size_t)(nt * 64 + nl2) * K + kt * 64 + kc) = w;
            }
        }
        __syncthreads();
    }
}

template <bool FIRST, bool FINAL>
DI void phase_norm1(const Args& a, int l, LAS unsigned char* lds, float cscale = 1.0f) {
    constexpr int NPRE = 4;
    const int tid = tidx(), lane = tid & 63, wid = tid >> 6;
    xres_t* X = (xres_t*)(a.ws + WS_X); bf16_t* XN = (bf16_t*)(a.ws + WS_XN);
    const float* MOD = (const float*)(a.ws + WS_MOD);
    const int* INV = (const int*)(a.ws + WS_R4 + R4_INV); const bf16_t* YE = (const bf16_t*)(a.ws + WS_R1);
    if (!FINAL && bidx() == 0 && tid < 72) ((unsigned*)(a.ws + WS_R4 + R4_KMAX))[tid] = 0u;
    constexpr int NR = FINAL ? NB * SEQ : NROW;
    const int rpb = (NR + gdim() - 1) / gdim(), j_lo = bidx() * rpb, j_hi = (j_lo + rpb < NR) ? j_lo + rpb : NR;
    const int b0 = FINAL ? (j_lo >> 13) : (j_lo / TPB);
    LAS float* g2l = (LAS float*)lds;
    LAS float* gsl = g2l + 3 * 1024;
    LAS float* shl = gsl + 3 * 1024;
    __syncthreads();
    for (int i = tid; i < 3 * 1024; i += NTHR) {
        const int st = i >> 10, c = i & 1023; int mrow = (st == 2) ? 8 : b0 + st; if (st < 2 && mrow > 7) mrow = 7;
        if (!FIRST) g2l[i] = MOD[((size_t)(l - 1) * 9 + mrow) * 6144 + 5 * 1024 + c] * cscale;
        if (FINAL) gsl[i] = a.final_g[c];
        else { const float* sh = MOD + ((size_t)l * 9 + mrow) * 6144; gsl[i] = a.norm1_g[(size_t)l * 1024 + c] * (1.0f + sh[1024 + c]); shl[i] = sh[c]; }
    }
    __syncthreads();
#define N1_ROWOF(j) (FINAL ? ((j) >> 13) * TPB + CTXL + ((j) & 8191) : (j))
    int j = j_lo + wid;
    if (FIRST) {
        f32x4 nx[4];
        if (j < j_hi) {
            const int b = j / TPB, pos = j % TPB;
            const float* src = (pos < CTXL) ? a.ctx + ((size_t)b * CTXL + pos) * 1024 : a.x + ((size_t)b * SEQ + (pos - CTXL)) * 1024;
#pragma unroll
            for (int i = 0; i < 4; ++i) nx[i] = *(const f32x4*)(src + 4 * lane + 256 * i);
        }
        for (; j < j_hi; j += NTHR / 64) {
            f32x4 v[4];
#pragma unroll
            for (int i = 0; i < 4; ++i) v[i] = nx[i];
            const int jn = j + NTHR / 64;
            if (jn < j_hi) {
                const int b = jn / TPB, pos = jn % TPB;
                const float* src = (pos < CTXL) ? a.ctx + ((size_t)b * CTXL + pos) * 1024 : a.x + ((size_t)b * SEQ + (pos - CTXL)) * 1024;
#pragma unroll
                for (int i = 0; i < 4; ++i) nx[i] = *(const f32x4*)(src + 4 * lane + 256 * i);
            }
            asm volatile("" ::: "memory");
            const int row = j, b = row / TPB, pos = row % TPB; const int st = (pos < CTXL) ? 2 : b - b0;
            float ss = 0.f;
#pragma unroll
            for (int i = 0; i < 4; ++i) ss += v[i][0] * v[i][0] + v[i][1] * v[i][1] + v[i][2] * v[i][2] + v[i][3] * v[i][3];
            ss = wave_sum(ss);
            const float rstd = rsqrtf(ss * (1.0f / 1024.0f) + EPS);
#pragma unroll
            for (int i = 0; i < 4; ++i) {
                const int c = 4 * lane + 256 * i;
                stx4(X + (size_t)row * 1024 + c, v[i]);
                const f32x4 y = v[i] * rstd * *(const LAS f32x4*)(gsl + st * 1024 + c) + *(const LAS f32x4*)(shl + st * 1024 + c);
                u32x2 w; w.x = pk2(y[0], y[1]); w.y = pk2(y[2], y[3]);
                *(u32x2*)(XN + (size_t)row * 1024 + c) = w;
            }
        }
    } else {
#ifndef X_F32
        typedef u32x2 xraw_t;
#define N1_XEXP(w) bf4(w)
#else
        typedef f32x4 xraw_t;
#define N1_XEXP(w) (w)
#endif
#define N1_LOADROW(ROW, INVV, XR, YR, SR, MREST) do { \
            _Pragma("unroll") for (int q = 0; q < NPRE; ++q) { SR[q] = -1; _Pragma("unroll") for (int i = 0; i < 4; ++i) YR[q][i] = (u32x2){0u, 0u}; } \
            MREST = 0ull; \
            if ((ROW) >= 0) { \
                _Pragma("unroll") for (int i = 0; i < 4; ++i) XR[i] = *(const xraw_t*)(X + (size_t)(ROW) * 1024 + 4 * lane + 256 * i); \
                unsigned long long mk_ = __ballot((INVV) >= 0) & 0xFFFFull; \
                _Pragma("unroll") for (int q = 0; q < NPRE; ++q) { \
                    if (mk_) { const int e_ = __builtin_ctzll(mk_); mk_ &= mk_ - 1; SR[q] = __builtin_amdgcn_readlane((INVV), e_); \
                        const bf16_t* yp_ = YE + (size_t)SR[q] * 1024; \
                        _Pragma("unroll") for (int i = 0; i < 4; ++i) YR[q][i] = *(const u32x2*)(yp_ + 4 * lane + 256 * i); } } \
                MREST = mk_; } } while (0)
        int rowc = (j < j_hi) ? N1_ROWOF(j) : -1;
        int rown = (j + 8 < j_hi) ? N1_ROWOF(j + 8) : -1;
        int invc = (rowc >= 0) ? INV[(size_t)rowc * 16 + (lane & 15)] : -1;
        int invn = (rown >= 0) ? INV[(size_t)rown * 16 + (lane & 15)] : -1;
        xraw_t xc[4]; u32x2 yc[NPRE][4]; int sc[NPRE]; unsigned long long mrc;
#pragma unroll
        for (int i = 0; i < 4; ++i) xc[i] = (xraw_t){};
        N1_LOADROW(rowc, invc, xc, yc, sc, mrc);
        for (; j < j_hi; j += NTHR / 64) {
            xraw_t xn[4]; u32x2 yn[NPRE][4]; int sn[NPRE]; unsigned long long mrn;
#pragma unroll
            for (int i = 0; i < 4; ++i) xn[i] = (xraw_t){};
            N1_LOADROW(rown, invn, xn, yn, sn, mrn);
            const int row2 = (j + 16 < j_hi) ? N1_ROWOF(j + 16) : -1;
            const int inv2 = (row2 >= 0) ? INV[(size_t)row2 * 16 + (lane & 15)] : -1;
            asm volatile("" ::: "memory");
            const int row = rowc, b = row / TPB, pos = row % TPB; const int st = (pos < CTXL) ? 2 : b - b0;
            f32x4 v[4], acc[4];
#pragma unroll
            for (int i = 0; i < 4; ++i) { v[i] = N1_XEXP(xc[i]); acc[i] = (f32x4){0.f, 0.f, 0.f, 0.f}; }
#pragma unroll
            for (int q = 0; q < NPRE; ++q)
                if (sc[q] >= 0) {
#pragma unroll
                    for (int i = 0; i < 4; ++i) acc[i] += bf4(yc[q][i]);
                }
            while (mrc) {
                const int e0 = __builtin_ctzll(mrc); mrc &= mrc - 1;
                const int s0 = __builtin_amdgcn_readlane(invc, e0);
                const bf16_t* y0 = YE + (size_t)s0 * 1024;
                u32x2 w0[4];
#pragma unroll
                for (int i = 0; i < 4; ++i) w0[i] = *(const u32x2*)(y0 + 4 * lane + 256 * i);
#pragma unroll
                for (int i = 0; i < 4; ++i) acc[i] += bf4(w0[i]);
            }
#pragma unroll
            for (int i = 0; i < 4; ++i) v[i] += *(const LAS f32x4*)(g2l + st * 1024 + 4 * lane + 256 * i) * acc[i];
            float ss = 0.f;
#pragma unroll
            for (int i = 0; i < 4; ++i) ss += v[i][0] * v[i][0] + v[i][1] * v[i][1] + v[i][2] * v[i][2] + v[i][3] * v[i][3];
            ss = wave_sum(ss);
            const float rstd = rsqrtf(ss * (1.0f / 1024.0f) + EPS);
            if (FINAL) {
                float* o = a.out + ((size_t)b * SEQ + (pos - CTXL)) * 1024;
#pragma unroll
                for (int i = 0; i < 4; ++i) *(f32x4*)(o + 4 * lane + 256 * i) = v[i] * rstd * *(const LAS f32x4*)(gsl + 4 * lane + 256 * i);
            } else {
#pragma unroll
                for (int i = 0; i < 4; ++i) {
                    const int c = 4 * lane + 256 * i;
                    stx4(X + (size_t)row * 1024 + c, v[i]);
                    const f32x4 y = v[i] * rstd * *(const LAS f32x4*)(gsl + st * 1024 + c) + *(const LAS f32x4*)(shl + st * 1024 + c);
                    u32x2 w; w.x = pk2(y[0], y[1]); w.y = pk2(y[2], y[3]);
                    *(u32x2*)(XN + (size_t)row * 1024 + c) = w;
                }
            }
#pragma unroll
            for (int i = 0; i < 4; ++i) xc[i] = xn[i];
#pragma unroll
            for (int q = 0; q < NPRE; ++q) { sc[q] = sn[q];
#pragma unroll
                for (int i = 0; i < 4; ++i) yc[q][i] = yn[q][i]; }
            mrc = mrn; rowc = rown; invc = invn; rown = row2; invn = inv2;
        }
#undef N1_LOADROW
#undef N1_XEXP
    }
#undef N1_ROWOF
    __syncthreads();
}

DI void phase_norm2_router(const Args& a, int l, LAS unsigned char* lds) {
    const int tid = tidx(), lane = tid & 63, wid = tid >> 6;
    LAS float* rw = (LAS float*)lds;
    LAS float* gsl = rw + 1024 * 20;
    LAS float* shl = gsl + 3 * 1024;
    const int rpb = (NROW + gdim() - 1) / gdim(), row_lo = bidx() * rpb, row_hi = (row_lo + rpb < NROW) ? row_lo + rpb : NROW;
    const int b0 = row_lo / TPB;
    const float* MOD = (const float*)(a.ws + WS_MOD);
    {
        const float* rsrc = a.router_w + (size_t)l * 1024 * 16;
        for (int i = tid; i < 1024 * 16; i += NTHR) { const int c = i >> 4; rw[((c & 3) * 256 + (c >> 2)) * 20 + (i & 15)] = rsrc[i]; }
        const float* g = a.norm2_g + (size_t)l * 1024;
        for (int i = tid; i < 3 * 1024; i += NTHR) {
            const int st = i >> 10, c = i & 1023; int mrow = (st == 2) ? 8 : b0 + st; if (mrow > 8) mrow = 8; if (st < 2 && mrow > 7) mrow = 7;
            const float* sh = MOD + ((size_t)l * 9 + mrow) * 6144 + 3 * 1024;
            gsl[i] = g[c] * (1.0f + sh[1024 + c]); shl[i] = sh[c];
        }
    }
    __syncthreads();
    const xres_t* X = (const xres_t*)(a.ws + WS_X); bf16_t* HX = (bf16_t*)(a.ws + WS_XN);
    float* AFF = (float*)(a.ws + WS_R4 + R4_AFF); int* INV = (int*)(a.ws + WS_R4 + R4_INV);
    int row = row_lo + wid;
#ifndef X_F32
    typedef u32x2 xr_t;
#define N2_EXP(w) bf4(w)
#else
    typedef f32x4 xr_t;
#define N2_EXP(w) (w)
#endif
    xr_t nx0[4], nx1[4], nx2[4];
#pragma unroll
    for (int i = 0; i < 4; ++i) { nx0[i] = (xr_t){}; nx1[i] = (xr_t){}; nx2[i] = (xr_t){}; }
    if (row < row_hi) {
#pragma unroll
        for (int i = 0; i < 4; ++i) nx0[i] = *(const xr_t*)(X + (size_t)row * 1024 + 4 * lane + 256 * i);
    }
    if (row + 8 < row_hi) {
#pragma unroll
        for (int i = 0; i < 4; ++i) nx1[i] = *(const xr_t*)(X + (size_t)(row + 8) * 1024 + 4 * lane + 256 * i);
    }
    if (row + 16 < row_hi) {
#pragma unroll
        for (int i = 0; i < 4; ++i) nx2[i] = *(const xr_t*)(X + (size_t)(row + 16) * 1024 + 4 * lane + 256 * i);
    }
    for (; row < row_hi; row += NTHR / 64) {
        f32x4 v[4];
#pragma unroll
        for (int i = 0; i < 4; ++i) { v[i] = N2_EXP(nx0[i]); nx0[i] = nx1[i]; nx1[i] = nx2[i]; }
        const int rown = row + 3 * (NTHR / 64);
        if (rown < row_hi) {
#pragma unroll
            for (int i = 0; i < 4; ++i) nx2[i] = *(const xr_t*)(X + (size_t)rown * 1024 + 4 * lane + 256 * i);
        }
        const int b = row / TPB, pos = row % TPB; const int st = (pos < CTXL) ? 2 : (b - b0);
        float ss = 0.f;
#pragma unroll
        for (int i = 0; i < 4; ++i) ss += v[i][0] * v[i][0] + v[i][1] * v[i][1] + v[i][2] * v[i][2] + v[i][3] * v[i][3];
        ss = wave_sum(ss);
        const float rstd = rsqrtf(ss * (1.0f / 1024.0f) + EPS);
        float lg[16];
        f32x2 lgp[8];
#pragma unroll
        for (int e = 0; e < 8; ++e) lgp[e] = (f32x2){0.f, 0.f};
#pragma unroll
        for (int i = 0; i < 4; ++i) {
            const int c = 4 * lane + 256 * i;
            const f32x4 gs4 = *(const LAS f32x4*)(gsl + st * 1024 + c), sh4 = *(const LAS f32x4*)(shl + st * 1024 + c);
            const f32x4 h4 = v[i] * rstd * gs4 + sh4;
            u32x2 w; w.x = pk2(h4[0], h4[1]); w.y = pk2(h4[2], h4[3]);
            *(u32x2*)(HX + (size_t)row * 1024 + c) = w;
            const f32x2 hp[2] = {(f32x2){h4[0], h4[1]}, (f32x2){h4[2], h4[3]}};
#pragma unroll
            for (int j = 0; j < 4; ++j) {
                const LAS f32x4* wp = (const LAS f32x4*)(rw + (j * 256 + lane + 64 * i) * 20);
#pragma unroll
                for (int q = 0; q < 4; ++q) {
                    const f32x4 w4 = wp[q];
                    const f32x2 wa = {w4[0], w4[1]}, wb = {w4[2], w4[3]};
                    if (j & 1) {
                        asm("v_pk_fma_f32 %0, %1, %2, %0 op_sel:[1,0,0] op_sel_hi:[1,1,1]" : "+v"(lgp[2 * q]) : "v"(hp[j >> 1]), "v"(wa));
                        asm("v_pk_fma_f32 %0, %1, %2, %0 op_sel:[1,0,0] op_sel_hi:[1,1,1]" : "+v"(lgp[2 * q + 1]) : "v"(hp[j >> 1]), "v"(wb));
                    } else {
                        asm("v_pk_fma_f32 %0, %1, %2, %0 op_sel_hi:[0,1,1]" : "+v"(lgp[2 * q]) : "v"(hp[j >> 1]), "v"(wa));
                        asm("v_pk_fma_f32 %0, %1, %2, %0 op_sel_hi:[0,1,1]" : "+v"(lgp[2 * q + 1]) : "v"(hp[j >> 1]), "v"(wb));
                    }
                }
            }
            asm volatile("" ::: "memory");
        }
#pragma unroll
        for (int e = 0; e < 8; ++e) { lg[2 * e] = lgp[e][0]; lg[2 * e + 1] = lgp[e][1]; }
#pragma unroll
        for (int i = 0; i < 8; ++i) lg[i] = tsum32(lg[i], lg[i + 8]);
#pragma unroll
        for (int i = 0; i < 4; ++i) lg[i] = tsum16(lg[i], lg[i + 4]);
#pragma unroll
        for (int i = 0; i < 2; ++i) { const bool up = lane & 8; const float send = up ? lg[i] : lg[i + 2], keep = up ? lg[i + 2] : lg[i]; lg[i] = keep + dppf<0x128>(send); }
        { const bool up = lane & 4; const float send = up ? lg[0] : lg[1], keep = up ? lg[1] : lg[0]; lg[0] = keep + dppf<0x1B>(dppf<0x141>(send)); }
        float t = lg[0]; t += dppf<0xB1>(t); t += dppf<0x4E>(t);
        const int e = lane & 15, srcl = ((e >> 3) & 1) * 32 + ((e >> 2) & 1) * 16 + ((e >> 1) & 1) * 8 + (e & 1) * 4;
        const float le = __shfl(t, srcl);
        const float mx = row_max16(le);
        const float ex = expf(le - mx);
        const float sm = row_sum16(ex);
        if (lane < 16) { AFF[(size_t)row * 16 + lane] = ex / sm; INV[(size_t)row * 16 + lane] = -1; }
    }
#undef N2_EXP
    __syncthreads();
}

DI void phase_topk(const Args& a, LAS unsigned char* lds) {
    const int tid = tidx(), lane = tid & 63, wid = tid >> 6;
    LAS unsigned* hist = (LAS unsigned*)lds;
    LAS unsigned* sh = hist + 256;
    const float* AFF = (const float*)(a.ws + WS_R4 + R4_AFF); int* INV = (int*)(a.ws + WS_R4 + R4_INV);
    int* SEL = (int*)(a.ws + WS_R4 + R4_SEL); float* GATEV = (float*)(a.ws + WS_R4 + R4_GATEV);
    for (int un = bidx(); un < 2 * NB * NEXP; un += gdim()) {
        const bool isctx = un >= NB * NEXP; const int ue = un % (NB * NEXP), b = ue / NEXP, e = ue % NEXP;
        const int n = isctx ? CTXL : SEQ, cap = isctx ? CAPC : CAPX, rowb = b * TPB + (isctx ? 0 : CTXL);
        const int slotb = e * EROWS + (isctx ? NB * CAPX + b * CAPC : b * CAPX);
        unsigned key[16];
#pragma unroll
        for (int i = 0; i < 16; ++i) { const int t = tid * 16 + i; key[i] = (t < n) ? __float_as_uint(AFF[(size_t)(rowb + t) * 16 + e]) : 0u; }
        unsigned prefix = 0u, kth = (unsigned)cap;
        for (int shift = 24; shift >= 0; shift -= 8) {
            if (tid < 256) hist[tid] = 0u;
            __syncthreads();
            const unsigned himask = (shift == 24) ? 0u : (0xFFFFFFFFu << (shift + 8));
#pragma unroll
            for (int i = 0; i < 16; ++i) { const int t = tid * 16 + i; if (t < n && (key[i] & himask) == prefix) __hip_atomic_fetch_add(&hist[(key[i] >> shift) & 255u], 1u, __ATOMIC_RELAXED, __HIP_MEMORY_SCOPE_WORKGROUP); }
            __syncthreads();
            if (tid < 64) {
                const unsigned c0 = hist[255 - 4 * lane], c1 = hist[254 - 4 * lane], c2 = hist[253 - 4 * lane], c3 = hist[252 - 4 * lane];
                const unsigned tot = c0 + c1 + c2 + c3;
                unsigned inc = tot;
#pragma unroll
                for (int o = 1; o < 64; o <<= 1) { const unsigned v = __shfl_up(inc, o); if (lane >= o) inc += v; }
                const unsigned long long bal = __ballot(inc >= kth);
                const int fl = __builtin_ctzll(bal);
                if (lane == fl) {
                    unsigned cum = inc - tot; int bin;
                    if (cum + c0 >= kth) bin = 255 - 4 * lane;
                    else { cum += c0; if (cum + c1 >= kth) bin = 254 - 4 * lane; else { cum += c1; if (cum + c2 >= kth) bin = 253 - 4 * lane; else { cum += c2; bin = 252 - 4 * lane; } } }
                    sh[0] = prefix | ((unsigned)bin << shift); sh[1] = kth - cum;
                }
            }
            __syncthreads();
            prefix = sh[0]; kth = sh[1];
            __syncthreads();
        }
        unsigned cnt = 0u;
#pragma unroll
        for (int i = 0; i < 16; ++i) { const int t = tid * 16 + i; if (t < n) { if (key[i] > prefix) cnt += 1u; else if (key[i] == prefix) cnt += 0x10000u; } }
        unsigned inc = cnt;
#pragma unroll
        for (int o = 1; o < 64; o <<= 1) { const unsigned v = __shfl_up(inc, o); if (lane >= o) inc += v; }
        if (lane == 63) sh[8 + wid] = inc;
        __syncthreads();
        unsigned base = 0u;
        for (int w = 0; w < wid; ++w) base += sh[8 + w];
        unsigned run = base + inc - cnt;
#pragma unroll
        for (int i = 0; i < 16; ++i) {
            const int t = tid * 16 + i;
            if (t < n) {
                const unsigned gtb = run & 0xFFFFu, eqb = run >> 16;
                bool take = false;
                if (key[i] > prefix) { take = true; run += 1u; }
                else if (key[i] == prefix) { take = eqb < kth; run += 0x10000u; }
                if (take) {
                    const int slot = slotb + (int)(gtb + (eqb < kth ? eqb : kth));
                    SEL[slot] = rowb + t; GATEV[slot] = __uint_as_float(key[i]); INV[(size_t)(rowb + t) * 16 + e] = slot;
                }
            }
        }
        __syncthreads();
    }
}
DI void phase_attention(const Args& a, int l, LAS unsigned char* lds) {
    const int tid = tidx(), lane = tid & 63, wid = tid >> 6, r = lane & 31, hh = lane >> 5;
    const bf16_t* Q = (const bf16_t*)(a.ws + WS_R2 + R2_Q); const bf16_t* KN = (const bf16_t*)(a.ws + WS_R2 + R2_KN);
    const bf16_t* VT = (const bf16_t*)(a.ws + WS_R2 + R2_VT); const bf16_t* KR = (const bf16_t*)(a.ws + WS_R2 + R2_KR);
    bf16_t* MIX = (bf16_t*)(a.ws + WS_XN);
    constexpr int KSTR = 208, VSTR = 144, KBUF = 64 * KSTR, VBUF = 64 * VSTR;
    LAS unsigned char* Kl = lds; LAS unsigned char* Vl = lds + 2 * KBUF;
    const int nun = NB * 8 * 32 + ((l < DEPTH - 1) ? NB * 8 : 0);
    const unsigned* KMAX = (const unsigned*)(a.ws + WS_R4 + R4_KMAX);
    for (int un = bidx(); un < nun; un += gdim()) {
        int b, h, qrow0, nt;
        int tstart = 0;
        if (un < NB * 8 * 32) { b = un >> 8; h = un & 7; qrow0 = b * TPB + CTXL + ((un >> 3) & 31) * 256; nt = TPB / 64; tstart = ((un >> 3) & 31) * 4; }
        else { const int u2 = un - NB * 8 * 32; b = u2 >> 3; h = u2 & 7; qrow0 = b * TPB; nt = CTXL / 64; }
        const int key0 = b * TPB;
        const int kk0 = tid / 12, kp0 = tid % 12, kk1 = (512 + (tid >> 1)) / 12, kp1 = (512 + (tid >> 1)) % 12;
        const bf16_t* kptr0 = (kp0 < 8) ? KN + (size_t)(key0 + kk0) * 512 + h * 64 + kp0 * 8 : KR + (size_t)(key0 + kk0) * 32 + (kp0 - 8) * 8;
        const bf16_t* kptr1 = (kp1 < 8) ? KN + (size_t)(key0 + kk1) * 512 + h * 64 + kp1 * 8 : KR + (size_t)(key0 + kk1) * 32 + (kp1 - 8) * 8;
        const bf16_t* kptr1h = kptr1 + 4 * (tid & 1);
        const unsigned kst0 = (kp0 < 8) ? 64 * 512 * 2 : 64 * 32 * 2, kst1 = (kp1 < 8) ? 64 * 512 * 2 : 64 * 32 * 2;
        const int ve = tid >> 3, vp = tid & 7;
        const bf16_t* vptr = VT + ((size_t)(b * 8 + h) * 64 + ve) * TPB + vp * 8;
        const unsigned char* wsb = a.ws;
        const unsigned ko0 = (unsigned)((const unsigned char*)kptr0 - wsb), ko1 = (unsigned)((const unsigned char*)kptr1h - wsb), vo = (unsigned)((const unsigned char*)vptr - wsb);
        const int kw0 = kk0 * KSTR + kp0 * 16, kw1 = kk1 * KSTR + kp1 * 16 + 8 * (tid & 1);
        const int vwl = ve * VSTR + (16 * (vp >> 1) + ((vp & 1) ? 4 : 0)) * 2, vwh = ve * VSTR + (16 * (vp >> 1) + ((vp & 1) ? 12 : 8)) * 2;
        bf16x8 qf[6];
        { const bf16_t* qp = Q + (size_t)(qrow0 + wid * 32 + r) * 768 + h * 96 + 8 * hh;
#pragma unroll
          for (int ks = 0; ks < 6; ++ks) qf[ks] = *(const bf16x8*)(qp + 16 * ks); }
        if (un < NB * 8 * 32) {
            const f32x2* RP = (const f32x2*)(a.ws + WS_ROPE);
            const int tp = qrow0 + wid * 32 + r - b * TPB - CTXL, rr = tp >> 6, cc = tp & 63;
            const f32x4* tr = (const f32x4*)(RP + rr * 8 + 4 * hh); const f32x4* tc = (const f32x4*)(RP + 1024 + cc * 8 + 4 * hh);
            const f32x4 r0 = tr[0], r1 = tr[1], c0 = tc[0], c1 = tc[1];
            const float csr[8] = {r0[0], r0[1], r0[2], r0[3], r1[0], r1[1], r1[2], r1[3]}, csc[8] = {c0[0], c0[1], c0[2], c0[3], c1[0], c1[1], c1[2], c1[3]};
            u32x4 w4, w5;
#pragma unroll
            for (int q = 0; q < 4; ++q) {
                const float a1 = bf2f((bf16_t)qf[4][2 * q]), a2 = bf2f((bf16_t)qf[4][2 * q + 1]);
                w4[q] = pk2(a1 * csr[2 * q] - a2 * csr[2 * q + 1], a1 * csr[2 * q + 1] + a2 * csr[2 * q]);
                const float b1 = bf2f((bf16_t)qf[5][2 * q]), b2 = bf2f((bf16_t)qf[5][2 * q + 1]);
                w5[q] = pk2(b1 * csc[2 * q] - b2 * csc[2 * q + 1], b1 * csc[2 * q + 1] + b2 * csc[2 * q]);
            }
            qf[4] = __builtin_bit_cast(bf16x8, w4); qf[5] = __builtin_bit_cast(bf16x8, w5);
        }
        bool fast;
        {
            float qn2 = 0.f;
#pragma unroll
            for (int ks = 0; ks < 6; ++ks)
#pragma unroll
                for (int jx = 0; jx < 8; ++jx) { const float qv = bf2f((bf16_t)qf[ks][jx]); qn2 += qv * qv; }
            qn2 = xor32_sum(qn2);
            const float kmax2 = __uint_as_float(KMAX[b * 8 + h]) + __uint_as_float(KMAX[64 + b]);
#ifdef PROBE_SAFE_ATTN
            fast = __all(qn2 * kmax2 < 0.0f) != 0;
#else
            fast = __all(qn2 * kmax2 < 90.0f * 90.0f) != 0;
#endif
        }
        f32x16 o0, o1, sA0, sA1, sB0, sB1;
#pragma unroll
        for (int i = 0; i < 16; ++i) { o0[i] = 0.f; o1[i] = 0.f; }
        float m_run = -1e30f, l_run = 0.f;
        __syncthreads();
        {
            const int t0 = tstart, t1 = (tstart + 1 >= nt) ? tstart + 1 - nt : tstart + 1;
            const u32x4 k0 = *(const u32x4*)(wsb + (ko0 + (unsigned)t0 * kst0)); const u32x2 k1 = *(const u32x2*)(wsb + (ko1 + (unsigned)t0 * kst1));
            const u32x4 v0 = *(const u32x4*)(wsb + (vo + (unsigned)t0 * 128u));
            const u32x4 k2 = *(const u32x4*)(wsb + (ko0 + (unsigned)t1 * kst0)); const u32x2 k3 = *(const u32x2*)(wsb + (ko1 + (unsigned)t1 * kst1));
            *(LAS u32x4*)(Kl + kw0) = k0; *(LAS u32x2*)(Kl + kw1) = k1;
            *(LAS u32x4*)(Kl + KBUF + kw0) = k2; *(LAS u32x2*)(Kl + KBUF + kw1) = k3;
            *(LAS u32x2*)(Vl + vwl) = (u32x2){v0.x, v0.y}; *(LAS u32x2*)(Vl + vwh) = (u32x2){v0.z, v0.w};
        }
        __syncthreads();
#define ATT_VF_QK(SN0, SN1) do { \
            _Pragma("unroll") for (int i = 0; i < 16; ++i) { SN0[i] = 0.f; SN1[i] = 0.f; } \
            _Pragma("unroll") for (int ks = 0; ks < 6; ++ks) { \
                const bf16x8 ka = *(const LAS bf16x8*)(kb_ + r * KSTR + ks * 32 + hh * 16); \
                const bf16x8 kb2 = *(const LAS bf16x8*)(kb_ + (32 + r) * KSTR + ks * 32 + hh * 16); \
                SN0 = MFMA32(ka, qf[ks], SN0); SN1 = MFMA32(kb2, qf[ks], SN1); \
                if (ks == 2) asm volatile("" ::: "memory");        \
            } } while (0)
#define ATT_STEP(KT, SC0, SC1, SN0, SN1, FAST, LK0, LK1, LV, WK0, WK1, WV) do { \
            const int kt_ = (KT); const int bufc = kt_ & 1; \
            int tk = kt_ + 2 + tstart, tv = kt_ + 1 + tstart; tk = (tk >= nt) ? tk - nt : tk; tk = (tk >= nt) ? tk - nt : tk; tv = (tv >= nt) ? tv - nt : tv; tv = (tv >= nt) ? tv - nt : tv; \
            LK0 = *(const u32x4*)(wsb + (ko0 + (unsigned)tk * kst0)); LK1 = *(const u32x2*)(wsb + (ko1 + (unsigned)tk * kst1)); \
            LV = *(const u32x4*)(wsb + (vo + (unsigned)tv * 128u)); \
            const LAS unsigned char* kb_ = Kl + (bufc ^ 1) * KBUF; \
            const LAS unsigned char* vb_ = Vl + bufc * VBUF; \
            float ps = 0.f; \
            bf16x8 vf[8]; \
            if (FAST) { \
                __builtin_amdgcn_s_setprio(2); \
                ATT_VF_QK(SN0, SN1); \
                _Pragma("unroll") for (int q = 0; q < 2; ++q) { vf[2 * q] = *(const LAS bf16x8*)(vb_ + r * VSTR + (16 * q + 8 * hh) * 2); vf[2 * q + 1] = *(const LAS bf16x8*)(vb_ + (32 + r) * VSTR + (16 * q + 8 * hh) * 2); }        \
                _Pragma("unroll") for (int i = 0; i < 16; ++i) { SC0[i] = __builtin_amdgcn_exp2f(SC0[i]); ps += SC0[i]; if (i < 8) { SC1[i] = __builtin_amdgcn_exp2f(SC1[i]); ps += SC1[i]; } }        \
                asm volatile("" : "+v"(ps)); \
            } else { \
                float mx = max3f(SC0[0], SC1[0], SC0[1]); mx = max3f(mx, SC1[1], SC0[2]); \
                _Pragma("unroll") for (int i = 2; i < 15; ++i) mx = max3f(mx, SC1[i], SC0[i + 1]); \
                mx = fmaxf(mx, SC1[15]); \
                mx = xor32_max(mx); \
                if (__any(mx > m_run + 8.0f)) {        \
                    const float m_new = fmaxf(m_run, mx), alpha = __builtin_amdgcn_exp2f(m_run - m_new); \
                    m_run = m_new; l_run *= alpha; \
                    _Pragma("unroll") for (int i = 0; i < 16; ++i) { o0[i] *= alpha; o1[i] *= alpha; } } \
                ATT_VF_QK(SN0, SN1); \
                _Pragma("unroll") for (int q = 0; q < 2; ++q) { vf[2 * q] = *(const LAS bf16x8*)(vb_ + r * VSTR + (16 * q + 8 * hh) * 2); vf[2 * q + 1] = *(const LAS bf16x8*)(vb_ + (32 + r) * VSTR + (16 * q + 8 * hh) * 2); } \
                _Pragma("unroll") for (int i = 0; i < 16; ++i) { SC0[i] = __builtin_amdgcn_exp2f(SC0[i] - m_run); SC1[i] = __builtin_amdgcn_exp2f(SC1[i] - m_run); ps += SC0[i]; ps += SC1[i]; } \
            } \
            if (!(FAST)) { l_run += ps; \
            asm volatile("" : "+v"(l_run)); }        \
            __builtin_amdgcn_sched_barrier(0); \
            __builtin_amdgcn_s_setprio(3); \
            _Pragma("unroll") for (int q = 2; q < 4; ++q) { vf[2 * q] = *(const LAS bf16x8*)(vb_ + r * VSTR + (16 * q + 8 * hh) * 2); vf[2 * q + 1] = *(const LAS bf16x8*)(vb_ + (32 + r) * VSTR + (16 * q + 8 * hh) * 2); } \
            _Pragma("unroll") for (int s = 0; s < 2; ++s) { \
                u32x4 pw; pw.x = pk2(SC0[8 * s], SC0[8 * s + 1]); pw.y = pk2(SC0[8 * s + 2], SC0[8 * s + 3]); pw.z = pk2(SC0[8 * s + 4], SC0[8 * s + 5]); pw.w = pk2(SC0[8 * s + 6], SC0[8 * s + 7]); \
                const bf16x8 pf = __builtin_bit_cast(bf16x8, pw); \
                o0 = MFMA32(vf[2 * s], pf, o0); o1 = MFMA32(vf[2 * s + 1], pf, o1); } \
            if (FAST) { _Pragma("unroll") for (int i = 8; i < 16; ++i) { SC1[i] = __builtin_amdgcn_exp2f(SC1[i]); ps += SC1[i]; }        \
                l_run += ps; asm volatile("" : "+v"(l_run)); } \
            _Pragma("unroll") for (int s = 0; s < 2; ++s) { \
                u32x4 pw; pw.x = pk2(SC1[8 * s], SC1[8 * s + 1]); pw.y = pk2(SC1[8 * s + 2], SC1[8 * s + 3]); pw.z = pk2(SC1[8 * s + 4], SC1[8 * s + 5]); pw.w = pk2(SC1[8 * s + 6], SC1[8 * s + 7]); \
                const bf16x8 pf = __builtin_bit_cast(bf16x8, pw); \
                o0 = MFMA32(vf[4 + 2 * s], pf, o0); o1 = MFMA32(vf[4 + 2 * s + 1], pf, o1); } \
            __builtin_amdgcn_s_setprio(0); \
            { LAS unsigned char* kd = Kl + bufc * KBUF; LAS unsigned char* vd = Vl + (bufc ^ 1) * VBUF; \
              *(LAS u32x4*)(kd + kw0) = WK0; *(LAS u32x2*)(kd + kw1) = WK1; \
              *(LAS u32x2*)(vd + vwl) = (u32x2){WV.x, WV.y}; *(LAS u32x2*)(vd + vwh) = (u32x2){WV.z, WV.w}; } \
            asm volatile("s_waitcnt lgkmcnt(0)" ::: "memory"); __builtin_amdgcn_s_barrier(); asm volatile("" ::: "memory");        \
            } while (0)
        {
#pragma unroll
            for (int i = 0; i < 16; ++i) { sA0[i] = 0.f; sA1[i] = 0.f; }
#pragma unroll
            for (int ks = 0; ks < 6; ++ks) {
                const bf16x8 ka = *(const LAS bf16x8*)(Kl + r * KSTR + ks * 32 + hh * 16);
                const bf16x8 kb2 = *(const LAS bf16x8*)(Kl + (32 + r) * KSTR + ks * 32 + hh * 16);
                sA0 = MFMA32(ka, qf[ks], sA0); sA1 = MFMA32(kb2, qf[ks], sA1);
            }
        }
        __syncthreads();
        u32x4 pa0 = (u32x4){0u, 0u, 0u, 0u}, pav = pa0; u32x2 pa1 = (u32x2){0u, 0u};
        if (fast) {
            for (int kt = 0; kt < nt; kt += 2) { ATT_STEP(kt, sA0, sA1, sB0, sB1, 1, pa0, pa1, pav, pa0, pa1, pav); ATT_STEP(kt + 1, sB0, sB1, sA0, sA1, 1, pa0, pa1, pav, pa0, pa1, pav); }
        } else {
            for (int kt = 0; kt < nt; kt += 2) { ATT_STEP(kt, sA0, sA1, sB0, sB1, 0, pa0, pa1, pav, pa0, pa1, pav); ATT_STEP(kt + 1, sB0, sB1, sA0, sA1, 0, pa0, pa1, pav, pa0, pa1, pav); }
        }
#undef ATT_STEP
#undef ATT_VF_QK
        const float lt = xor32_sum(l_run), inv = 1.0f / lt;
        bf16_t* op = MIX + (size_t)(qrow0 + wid * 32 + r) * 1024 + 512 + h * 64 + 4 * hh;
#pragma unroll
        for (int g = 0; g < 4; ++g) {
            u32x2 w0; w0.x = pk2(o0[4 * g] * inv, o0[4 * g + 1] * inv); w0.y = pk2(o0[4 * g + 2] * inv, o0[4 * g + 3] * inv);
            u32x2 w1; w1.x = pk2(o1[4 * g] * inv, o1[4 * g + 1] * inv); w1.y = pk2(o1[4 * g + 2] * inv, o1[4 * g + 3] * inv);
            *(u32x2*)(op + 8 * g) = w0; *(u32x2*)(op + 32 + 8 * g) = w1;
        }
    }
}

struct ConvRaw { u32x4 c0, c1, a0, a1, n0, n1; };
DI ConvRaw conv16_load(const bf16_t* U, size_t row, int col, bool hasp, bool hasn) {
    const bf16_t* p = U + row * UW + col;
    ConvRaw r; r.c0 = *(const u32x4*)p; r.c1 = *(const u32x4*)(p + 8);
    r.a0 = (u32x4){0u, 0u, 0u, 0u}; r.a1 = r.a0; r.n0 = r.a0; r.n1 = r.a0;
    if (hasp) { r.a0 = *(const u32x4*)(p - UW); r.a1 = *(const u32x4*)(p - UW + 8); }
    if (hasn) { r.n0 = *(const u32x4*)(p + UW); r.n1 = *(const u32x4*)(p + UW + 8); }
    return r;
}
DI void conv16_compute(const ConvRaw& r, const float* cw, const float* cb, int ch, float scale, float (&out)[16]) {
    const unsigned cu[8] = {r.c0.x, r.c0.y, r.c0.z, r.c0.w, r.c1.x, r.c1.y, r.c1.z, r.c1.w};
    const unsigned au[8] = {r.a0.x, r.a0.y, r.a0.z, r.a0.w, r.a1.x, r.a1.y, r.a1.z, r.a1.w};
    const unsigned nu[8] = {r.n0.x, r.n0.y, r.n0.z, r.n0.w, r.n1.x, r.n1.y, r.n1.z, r.n1.w};
    f32x4 w0[4], w1[4], w2[4], bb[4];
#pragma unroll
    for (int q = 0; q < 4; ++q) { w0[q] = *(const f32x4*)(cw + ch + 4 * q); w1[q] = *(const f32x4*)(cw + 512 + ch + 4 * q); w2[q] = *(const f32x4*)(cw + 1024 + ch + 4 * q); bb[q] = *(const f32x4*)(cb + ch + 4 * q); }
#pragma unroll
    for (int i = 0; i < 8; ++i) {
#pragma unroll
        for (int q = 0; q < 2; ++q) {
            const int k = 2 * i + q;
            const float xc = q ? __uint_as_float(cu[i] & 0xffff0000u) : __uint_as_float(cu[i] << 16);
            const float xa = q ? __uint_as_float(au[i] & 0xffff0000u) : __uint_as_float(au[i] << 16);
            const float xn = q ? __uint_as_float(nu[i] & 0xffff0000u) : __uint_as_float(nu[i] << 16);
            const float y = w0[k >> 2][k & 3] * xa + w1[k >> 2][k & 3] * xc + w2[k >> 2][k & 3] * xn + bb[k >> 2][k & 3];
            out[k] = silu_f(y) * scale;
        }
    }
}
DI void conv16(const bf16_t* U, size_t row, int col, bool hasp, bool hasn, const float* cw, const float* cb, int ch, float scale, float (&out)[16]) {
    const ConvRaw r = conv16_load(U, row, col, hasp, hasn); conv16_compute(r, cw, cb, ch, scale, out);
}

DI void mlstm_gates(const Args& a, int l, int h, size_t row0, LAS float* logi, LAS float* logf, LAS float* bcum, LAS float* gg, LAS float* pmx, LAS float* sc) {
    const int tid = tidx();
    const float* GT = (const float*)(a.ws + WS_R4 + R4_GATES);
    if (tid < 256) {
        const int dir = tid >> 7, s = tid & 127;
        const float gi = GT[(row0 + s) * 16 + dir * 8 + h] + a.m_ib[l * 8 + dir * 4 + h];
        const float gf = GT[(row0 + s) * 16 + dir * 8 + 4 + h] + a.m_fb[l * 8 + dir * 4 + h];
        logi[dir * 128 + s] = gi;
        logf[dir * 128 + s] = fminf(gf, 0.f) - log1pf(expf(-fabsf(gf)));
    }
    __syncthreads();
    if (tid < 128) {
        const int dir = tid >> 6, ln = tid & 63;
        const int s0 = dir ? 127 - 2 * ln : 2 * ln, s1 = dir ? s0 - 1 : s0 + 1;
        const float f0 = logf[dir * 128 + s0], f1 = logf[dir * 128 + s1];
        float inc = f0 + f1;
#pragma unroll
        for (int o = 1; o < 64; o <<= 1) { const float v = __shfl_up(inc, o); if (ln >= o) inc += v; }
        const float exc = inc - (f0 + f1), b0 = exc + f0, b1 = exc + f0 + f1;
        const float g0 = logi[dir * 128 + s0] - b0, g1 = logi[dir * 128 + s1] - b1;
        float mi_ = fmaxf(g0, g1);
#pragma unroll
        for (int o = 1; o < 64; o <<= 1) { const float v = __shfl_up(mi_, o); if (ln >= o) mi_ = fmaxf(mi_, v); }
        float mex = __shfl_up(mi_, 1); if (ln == 0) mex = -1e30f;
        bcum[dir * 128 + s0] = b0; bcum[dir * 128 + s1] = b1; gg[dir * 128 + s0] = g0; gg[dir * 128 + s1] = g1;
        pmx[dir * 128 + s0] = fmaxf(mex, g0); pmx[dir * 128 + s1] = fmaxf(mex, fmaxf(g0, g1));
        if (ln == 63) { sc[dir * 4 + 0] = inc; sc[dir * 4 + 1] = mi_; }
    }
    __syncthreads();
}

DI void phase_mlstm_local(const Args& a, int l, LAS unsigned char* lds) {
    const int tid = tidx(), lane = tid & 63, wid = tid >> 6, r = lane & 31, hh = lane >> 5;
    constexpr int RS = 272;
    LAS unsigned char* KwT = lds;
    LAS unsigned char* VTl = lds + 2 * 64 * RS;
    LAS float* fl = (LAS float*)(lds + 3 * 64 * RS);
    LAS float* logi = fl, *logf = fl + 256, *bcum = fl + 512, *gg = fl + 768, *pmx = fl + 1024, *ww = fl + 1280, *sc = fl + 1536;
    const bf16_t* U = (const bf16_t*)(a.ws + WS_R1);
    float* MST = (float*)(a.ws + WS_R4 + R4_MST); float* MSC = (float*)(a.ws + WS_R4 + R4_MSC);
    const float* cw = a.m_conv_w + (size_t)l * 3 * 512; const float* cb = a.m_conv_b + (size_t)l * 512;
    for (int un = (bidx() + 128) % gdim(); un < NB * 4 * NCHUNK; un += gdim()) {
        const int b = un / (4 * NCHUNK), h = (un / NCHUNK) % 4, j = un % NCHUNK;
        const size_t row0 = (size_t)b * TPB + 128 * j;
        const int s = tid & 127, d0 = (tid >> 7) * 16;
        const bool hasp = !(s == 0 && (j == 0 || j == 2)), hasn = !(s == 127 && (j == 1 || j == NCHUNK - 1));
        const ConvRaw rk = conv16_load(U, row0 + s, U_K + 64 * h + d0, hasp, hasn);
        const bf16_t* vp = U + (row0 + s) * UW + U_V + 64 * h + d0;
        const u32x4 v0 = *(const u32x4*)vp, v1 = *(const u32x4*)(vp + 8);
        mlstm_gates(a, l, h, row0, logi, logf, bcum, gg, pmx, sc);
        if (tid < 256) { const int dir = tid >> 7; ww[tid] = expf(gg[tid] - sc[dir * 4 + 1]); }
        __syncthreads();
        {
            float kv[16];
            conv16_compute(rk, cw, cb, 256 + 64 * h + d0, 1.0f, kv);
            const float w0 = ww[s], w1 = ww[128 + s];
#pragma unroll
            for (int k = 0; k < 16; ++k) {
                *(LAS bf16_t*)(KwT + (d0 + k) * RS + s * 2) = f2bf(kv[k] * w0);
                *(LAS bf16_t*)(KwT + (64 + d0 + k) * RS + s * 2) = f2bf(kv[k] * w1);
            }
            const unsigned vu[8] = {v0.x, v0.y, v0.z, v0.w, v1.x, v1.y, v1.z, v1.w};
#pragma unroll
            for (int i = 0; i < 8; ++i) {
                *(LAS bf16_t*)(VTl + (d0 + 2 * i) * RS + s * 2) = (bf16_t)(vu[i] & 0xffffu);
                *(LAS bf16_t*)(VTl + (d0 + 2 * i + 1) * RS + s * 2) = (bf16_t)(vu[i] >> 16);
            }
        }
        __syncthreads();
        {
            const int dir = wid >> 2, eb = (wid >> 1) & 1, db = wid & 1;
            f32x16 acc;
#pragma unroll
            for (int i = 0; i < 16; ++i) acc[i] = 0.f;
#pragma unroll
            for (int ks = 0; ks < 8; ++ks) {
                const bf16x8 av = *(const LAS bf16x8*)(VTl + (32 * eb + r) * RS + ks * 32 + hh * 16);
                const bf16x8 bk = *(const LAS bf16x8*)(KwT + (dir * 64 + 32 * db + r) * RS + ks * 32 + hh * 16);
                acc = MFMA32(av, bk, acc);
            }
            const size_t rec = ((size_t)(b * 4 + h) * NCHUNK + j) * 2 + dir;
            float* dst = MST + rec * MREC;
#pragma unroll
            for (int i = 0; i < 16; ++i) dst[(32 * eb + crow(i, hh)) * 64 + 32 * db + r] = acc[i];
        }
        if (tid < 128) {
            const int dir = tid >> 6, d = tid & 63;
            const LAS bf16_t* kr = (const LAS bf16_t*)(KwT + (dir * 64 + d) * RS);
            float sum = 0.f;
            for (int s = 0; s < 128; ++s) sum += bf2f(kr[s]);
            const size_t rec = ((size_t)(b * 4 + h) * NCHUNK + j) * 2 + dir;
            MST[rec * MREC + 4096 + d] = sum;
            if (d == 0) { MSC[rec * 4 + 0] = sc[dir * 4 + 0] + sc[dir * 4 + 1]; MSC[rec * 4 + 1] = sc[dir * 4 + 0]; }
        }
        __syncthreads();
    }
}

DI void phase_mlstm_scan(const Args& a) {
    float* MST = (float*)(a.ws + WS_R4 + R4_MST); float* MSC = (float*)(a.ws + WS_R4 + R4_MSC);
    const int tid = tidx();
    for (int blk = bidx(); blk < NB * 4 * 2 * 8; blk += gdim()) {
        const int seq = blk >> 3, el = (blk & 7) * NTHR + tid, dir = seq & 1, bh = seq >> 1;
        const bool ex = el < 64;
        float C = 0.f, C2 = 0.f, m = 0.f;
        for (int st0 = 0; st0 < NCHUNK; st0 += 11) {
            float loc[11], loc2[11], ml[11], bt[11];
#pragma unroll
            for (int q = 0; q < 11; ++q) {
                const int st = st0 + q, j = dir ? (st < 2 ? 1 - st : NCHUNK + 1 - st) : st;
                const size_t rec = ((size_t)bh * NCHUNK + j) * 2 + dir;
                loc[q] = MST[rec * MREC + el]; ml[q] = MSC[rec * 4 + 0]; bt[q] = MSC[rec * 4 + 1];
                loc2[q] = ex ? MST[rec * MREC + 4096 + el] : 0.f;
            }
#pragma unroll
            for (int q = 0; q < 11; ++q) {
                const int st = st0 + q, j = dir ? (st < 2 ? 1 - st : NCHUNK + 1 - st) : st;
                const size_t rec = ((size_t)bh * NCHUNK + j) * 2 + dir;
                MST[rec * MREC + el] = C;
                if (ex) MST[rec * MREC + 4096 + el] = C2;
                if (el == 0) MSC[rec * 4 + 2] = m;
                const float m_new = fmaxf(bt[q] + m, ml[q]);
                const float f1 = expf(bt[q] + m - m_new), f2 = expf(ml[q] - m_new);
                C = f1 * C + f2 * loc[q];
                C2 = f1 * C2 + f2 * loc2[q];
                m = m_new;
            }
        }
    }
}

DI void phase_mlstm_out(const Args& a, int l, LAS unsigned char* lds) {
    const int tid = tidx(), lane = tid & 63, wid = tid >> 6, r = lane & 31, hh = lane >> 5;
    constexpr int QS = 144, RS = 272;
    LAS unsigned char* Qs = lds;
    LAS unsigned char* Ks = Qs + 128 * QS;
    LAS unsigned char* VTl = Ks + 128 * QS;
    LAS unsigned char* Cs = VTl + 64 * RS;
    LAS float* fl = (LAS float*)(Cs + 2 * 64 * QS);
    LAS float* logi = fl, *logf = fl + 256, *bcum = fl + 512, *gg = fl + 768, *pmx = fl + 1024, *ns = fl + 1280  , *sc = fl + 1408  , *mi = fl + 1416  ;
    LAS float* Hb = fl + 1424;
    const bf16_t* U = (const bf16_t*)(a.ws + WS_R1); bf16_t* MIX = (bf16_t*)(a.ws + WS_XN);
    const float* MST = (const float*)(a.ws + WS_R4 + R4_MST); const float* MSC = (const float*)(a.ws + WS_R4 + R4_MSC);
    const float* cw = a.m_conv_w + (size_t)l * 3 * 512; const float* cb = a.m_conv_b + (size_t)l * 512;
    const int nun = (l < DEPTH - 1) ? NB * 4 * NCHUNK : NB * 4 * (NCHUNK - 2);
    for (int un = (bidx() + 128) % gdim(); un < nun; un += gdim()) {
        int b, h, j;
        if (l < DEPTH - 1) { b = un / (4 * NCHUNK); h = (un / NCHUNK) % 4; j = un % NCHUNK; }
        else { b = un / (4 * (NCHUNK - 2)); h = (un / (NCHUNK - 2)) % 4; j = 2 + un % (NCHUNK - 2); }
        const size_t row0 = (size_t)b * TPB + 128 * j;
        const size_t rec0 = ((size_t)(b * 4 + h) * NCHUNK + j) * 2;
        const int s = tid & 127, d0 = (tid >> 7) * 16;
        const bool hasp = !(s == 0 && (j == 0 || j == 2)), hasn = !(s == 127 && (j == 1 || j == NCHUNK - 1));
        const ConvRaw rq = conv16_load(U, row0 + s, U_Q + 64 * h + d0, hasp, hasn), rk = conv16_load(U, row0 + s, U_K + 64 * h + d0, hasp, hasn);
        const bf16_t* vp = U + (row0 + s) * UW + U_V + 64 * h + d0;
        const u32x4 v0 = *(const u32x4*)vp, v1 = *(const u32x4*)(vp + 8);
        const int cdir = tid >> 8, ce = (tid >> 2) & 63, cd0 = (tid & 3) * 16;
        const float* cp = MST + (rec0 + cdir) * MREC + ce * 64 + cd0;
        const f32x4 c0 = *(const f32x4*)cp, c1 = *(const f32x4*)(cp + 4), c2 = *(const f32x4*)(cp + 8), c3 = *(const f32x4*)(cp + 12);
        mlstm_gates(a, l, h, row0, logi, logf, bcum, gg, pmx, sc);
        {
            float tv[16];
            conv16_compute(rq, cw, cb, 64 * h + d0, 0.125f, tv);
            { u32x4 w0, w1; w0.x = pk2(tv[0], tv[1]); w0.y = pk2(tv[2], tv[3]); w0.z = pk2(tv[4], tv[5]); w0.w = pk2(tv[6], tv[7]); w1.x = pk2(tv[8], tv[9]); w1.y = pk2(tv[10], tv[11]); w1.z = pk2(tv[12], tv[13]); w1.w = pk2(tv[14], tv[15]);
              *(LAS u32x4*)(Qs + s * QS + d0 * 2) = w0; *(LAS u32x4*)(Qs + s * QS + d0 * 2 + 16) = w1; }
            conv16_compute(rk, cw, cb, 256 + 64 * h + d0, 1.0f, tv);
            { u32x4 w0, w1; w0.x = pk2(tv[0], tv[1]); w0.y = pk2(tv[2], tv[3]); w0.z = pk2(tv[4], tv[5]); w0.w = pk2(tv[6], tv[7]); w1.x = pk2(tv[8], tv[9]); w1.y = pk2(tv[10], tv[11]); w1.z = pk2(tv[12], tv[13]); w1.w = pk2(tv[14], tv[15]);
              *(LAS u32x4*)(Ks + s * QS + d0 * 2) = w0; *(LAS u32x4*)(Ks + s * QS + d0 * 2 + 16) = w1; }
            const unsigned vu[8] = {v0.x, v0.y, v0.z, v0.w, v1.x, v1.y, v1.z, v1.w};
#pragma unroll
            for (int i = 0; i < 8; ++i) {
                *(LAS bf16_t*)(VTl + (d0 + 2 * i) * RS + s * 2) = (bf16_t)(vu[i] & 0xffffu);
                *(LAS bf16_t*)(VTl + (d0 + 2 * i + 1) * RS + s * 2) = (bf16_t)(vu[i] >> 16);
            }
            u32x4 w0, w1; w0.x = pk2(c0[0], c0[1]); w0.y = pk2(c0[2], c0[3]); w0.z = pk2(c1[0], c1[1]); w0.w = pk2(c1[2], c1[3]); w1.x = pk2(c2[0], c2[1]); w1.y = pk2(c2[2], c2[3]); w1.z = pk2(c3[0], c3[1]); w1.w = pk2(c3[2], c3[3]);
            *(LAS u32x4*)(Cs + (cdir * 64 + ce) * QS + cd0 * 2) = w0; *(LAS u32x4*)(Cs + (cdir * 64 + ce) * QS + cd0 * 2 + 16) = w1;
            if (tid < 128) ns[tid] = MST[(rec0 + (tid >> 6)) * MREC + 4096 + (tid & 63)];
            if (tid < 2) mi[tid] = MSC[(rec0 + tid) * 4 + 2];
        }
        __syncthreads();
        const int dir = wid >> 2, tb = wid & 3, t = 32 * tb + r;
        const float m_in = mi[dir];
        const float Mt = fmaxf(m_in, pmx[dir * 128 + t]);
        const float a_t = expf(m_in - Mt);
        bf16x8 qf[4];
#pragma unroll
        for (int ks = 0; ks < 4; ++ks) qf[ks] = *(const LAS bf16x8*)(Qs + t * QS + ks * 32 + hh * 16);
        f32x16 o0, o1;
#pragma unroll
        for (int i = 0; i < 16; ++i) { o0[i] = 0.f; o1[i] = 0.f; }
        float qn = 0.f;
#pragma unroll
        for (int ks = 0; ks < 4; ++ks) {
            const bf16x8 c0 = *(const LAS bf16x8*)(Cs + (dir * 64 + r) * QS + ks * 32 + hh * 16);
            const bf16x8 c1 = *(const LAS bf16x8*)(Cs + (dir * 64 + 32 + r) * QS + ks * 32 + hh * 16);
            o0 = MFMA32(c0, qf[ks], o0); o1 = MFMA32(c1, qf[ks], o1);
#pragma unroll
            for (int jx = 0; jx < 8; ++jx) qn += bf2f((bf16_t)qf[ks][jx]) * ns[dir * 64 + ks * 16 + hh * 8 + jx];
        }
        qn = xor32_sum(qn);
#pragma unroll
        for (int i = 0; i < 16; ++i) { o0[i] *= a_t; o1[i] *= a_t; }
        float rs = 0.f;
        const int sb_lo = dir ? tb : 0, sb_hi = dir ? 3 : tb;
        for (int sb = sb_lo; sb <= sb_hi; ++sb) {
            f32x16 sv;
#pragma unroll
            for (int i = 0; i < 16; ++i) sv[i] = 0.f;
#pragma unroll
            for (int ks = 0; ks < 4; ++ks) {
                const bf16x8 ka = *(const LAS bf16x8*)(Ks + (32 * sb + r) * QS + ks * 32 + hh * 16);
                sv = MFMA32(ka, qf[ks], sv);
            }
#pragma unroll
            for (int i = 0; i < 16; ++i) {
                const int s = 32 * sb + crow(i, hh);
                const bool valid = dir ? (s >= t) : (s <= t);
                const float wgt = valid ? expf(gg[dir * 128 + s] - Mt) : 0.f;
                sv[i] *= wgt; rs += sv[i];
            }
#pragma unroll
            for (int ss = 0; ss < 2; ++ss) {
                u32x4 pw; pw.x = pk2(sv[8 * ss], sv[8 * ss + 1]); pw.y = pk2(sv[8 * ss + 2], sv[8 * ss + 3]); pw.z = pk2(sv[8 * ss + 4], sv[8 * ss + 5]); pw.w = pk2(sv[8 * ss + 6], sv[8 * ss + 7]);
                const bf16x8 pf = __builtin_bit_cast(bf16x8, pw);
                const int koff = (32 * sb + 16 * ss + 4 * hh) * 2;
                const s16x4 va0 = *(const LAS s16x4*)(VTl + r * RS + koff), va1 = *(const LAS s16x4*)(VTl + r * RS + koff + 16);
                const s16x4 vb0 = *(const LAS s16x4*)(VTl + (32 + r) * RS + koff), vb1 = *(const LAS s16x4*)(VTl + (32 + r) * RS + koff + 16);
                o0 = MFMA32(__builtin_shufflevector(va0, va1, 0, 1, 2, 3, 4, 5, 6, 7), pf, o0);
                o1 = MFMA32(__builtin_shufflevector(vb0, vb1, 0, 1, 2, 3, 4, 5, 6, 7), pf, o1);
            }
        }
        rs = xor32_sum(rs);
        const float den = a_t * qn + rs, mt = bcum[dir * 128 + t] + Mt;
        const float dd = 1.0f / fmaxf(fabsf(den), expf(-mt));
#pragma unroll
        for (int i = 0; i < 16; ++i) { o0[i] *= dd; o1[i] *= dd; }
        if (dir == 1) {
#pragma unroll
            for (int i = 0; i < 16; ++i) { Hb[t * 65 + crow(i, hh)] = o0[i]; Hb[t * 65 + 32 + crow(i, hh)] = o1[i]; }
        }
        __syncthreads();
        if (dir == 0) {
            float ssq = 0.f;
#pragma unroll
            for (int i = 0; i < 16; ++i) { o0[i] += Hb[t * 65 + crow(i, hh)]; o1[i] += Hb[t * 65 + 32 + crow(i, hh)]; ssq += o0[i] * o0[i] + o1[i] * o1[i]; }
            ssq = xor32_sum(ssq);
            const float rstd = rsqrtf(ssq * (1.0f / 64.0f) + EPS);
            const float* gn = a.m_norm_g + (size_t)l * 256 + 64 * h;
            const bf16_t* og = U + (row0 + t) * UW + U_O + 64 * h;
            bf16_t* op = MIX + (row0 + t) * 1024 + 256 + 64 * h;
#pragma unroll
            for (int g = 0; g < 4; ++g) {
#pragma unroll
                for (int eb = 0; eb < 2; ++eb) {
                    const int e0 = 32 * eb + 8 * g + 4 * hh;
                    const u32x2 ow = *(const u32x2*)(og + e0);
                    const float og0 = __uint_as_float(ow.x << 16), og1 = __uint_as_float(ow.x & 0xffff0000u), og2 = __uint_as_float(ow.y << 16), og3 = __uint_as_float(ow.y & 0xffff0000u);
                    const float h0 = (eb ? o1[4 * g] : o0[4 * g]), h1 = (eb ? o1[4 * g + 1] : o0[4 * g + 1]), h2 = (eb ? o1[4 * g + 2] : o0[4 * g + 2]), h3 = (eb ? o1[4 * g + 3] : o0[4 * g + 3]);
                    u32x2 w; w.x = pk2(h0 * rstd * gn[e0] * sigmoid_f(og0), h1 * rstd * gn[e0 + 1] * sigmoid_f(og1));
                    w.y = pk2(h2 * rstd * gn[e0 + 2] * sigmoid_f(og2), h3 * rstd * gn[e0 + 3] * sigmoid_f(og3));
                    *(u32x2*)(op + e0) = w;
                }
            }
        }
        __syncthreads();
    }
}

DI void mlstm_gates_half(const Args& a, int l, int h, size_t row0, int ht, LAS float* logi, LAS float* logf, LAS float* bcum, LAS float* gg, LAS float* pmx, LAS float* sc) {
    const float* GT = (const float*)(a.ws + WS_R4 + R4_GATES);
    {
        const int dir = ht >> 7, s = ht & 127;
        const float gi = GT[(row0 + s) * 16 + dir * 8 + h] + a.m_ib[l * 8 + dir * 4 + h];
        const float gf = GT[(row0 + s) * 16 + dir * 8 + 4 + h] + a.m_fb[l * 8 + dir * 4 + h];
        logi[dir * 128 + s] = gi;
        logf[dir * 128 + s] = fminf(gf, 0.f) - log1pf(expf(-fabsf(gf)));
    }
    __syncthreads();
    if (ht < 128) {
        const int dir = ht >> 6, ln = ht & 63;
        const int s0 = dir ? 127 - 2 * ln : 2 * ln, s1 = dir ? s0 - 1 : s0 + 1;
        const float f0 = logf[dir * 128 + s0], f1 = logf[dir * 128 + s1];
        float inc = f0 + f1;
#pragma unroll
        for (int o = 1; o < 64; o <<= 1) { const float v = __shfl_up(inc, o); if (ln >= o) inc += v; }
        const float exc = inc - (f0 + f1), b0 = exc + f0, b1 = exc + f0 + f1;
        const float g0 = logi[dir * 128 + s0] - b0, g1 = logi[dir * 128 + s1] - b1;
        float mi_ = fmaxf(g0, g1);
#pragma unroll
        for (int o = 1; o < 64; o <<= 1) { const float v = __shfl_up(mi_, o); if (ln >= o) mi_ = fmaxf(mi_, v); }
        float mex = __shfl_up(mi_, 1); if (ln == 0) mex = -1e30f;
        bcum[dir * 128 + s0] = b0; bcum[dir * 128 + s1] = b1; gg[dir * 128 + s0] = g0; gg[dir * 128 + s1] = g1;
        pmx[dir * 128 + s0] = fmaxf(mex, g0); pmx[dir * 128 + s1] = fmaxf(mex, fmaxf(g0, g1));
        if (ln == 63) { sc[dir * 4 + 0] = inc; sc[dir * 4 + 1] = mi_; }
    }
    __syncthreads();
}

DI void phase_mlstm_out2(const Args& a, int l, LAS unsigned char* lds) {
    const int tid = tidx(), lane = tid & 63, wid = tid >> 6, r = lane & 31, hh = lane >> 5;
    const int half = wid >> 2, tb = wid & 3, ht = tid & 255;
    constexpr int QS = 144, RS = 272, HB = 78848;
    LAS unsigned char* hb = lds + half * HB;
    LAS unsigned char* Qs = hb;
    LAS unsigned char* Ks = Qs + 128 * QS;
    LAS unsigned char* VTl = Ks + 128 * QS;
    LAS unsigned char* Cs = VTl + 64 * RS;
    LAS float* fl = (LAS float*)(Cs + 2 * 64 * QS);
    LAS float* logi = fl, *logf = fl + 256, *bcum = fl + 512, *gg = fl + 768, *pmx = fl + 1024, *ns = fl + 1280  , *sc = fl + 1408  , *mi = fl + 1416  ;
    const bf16_t* U = (const bf16_t*)(a.ws + WS_R1); bf16_t* MIX = (bf16_t*)(a.ws + WS_XN);
    const float* MST = (const float*)(a.ws + WS_R4 + R4_MST); const float* MSC = (const float*)(a.ws + WS_R4 + R4_MSC);
    const float* cw = a.m_conv_w + (size_t)l * 3 * 512; const float* cb = a.m_conv_b + (size_t)l * 512;
    const int nun = (l < DEPTH - 1) ? NB * 4 * NCHUNK : NB * 4 * (NCHUNK - 2);
    for (int pi = (bidx() + 128) % gdim(); 2 * pi < nun; pi += gdim()) {
        const int un = 2 * pi + half;
        int b, h, j;
        if (l < DEPTH - 1) { b = un / (4 * NCHUNK); h = (un / NCHUNK) % 4; j = un % NCHUNK; }
        else { b = un / (4 * (NCHUNK - 2)); h = (un / (NCHUNK - 2)) % 4; j = 2 + un % (NCHUNK - 2); }
        const size_t row0 = (size_t)b * TPB + 128 * j;
        const size_t rec0 = ((size_t)(b * 4 + h) * NCHUNK + j) * 2;
        const int s = ht & 127, dq = (ht >> 7) * 32;
        const bool hasp = !(s == 0 && (j == 0 || j == 2)), hasn = !(s == 127 && (j == 1 || j == NCHUNK - 1));
        const ConvRaw rq0 = conv16_load(U, row0 + s, U_Q + 64 * h + dq, hasp, hasn), rk0 = conv16_load(U, row0 + s, U_K + 64 * h + dq, hasp, hasn);
        const bf16_t* vp = U + (row0 + s) * UW + U_V + 64 * h + dq;
        const u32x4 v0 = *(const u32x4*)vp, v1 = *(const u32x4*)(vp + 8), v2 = *(const u32x4*)(vp + 16), v3 = *(const u32x4*)(vp + 24);
        mlstm_gates_half(a, l, h, row0, ht, logi, logf, bcum, gg, pmx, sc);
        {
            const int cdir = ht >> 7, ce = (ht >> 1) & 63, cd0 = (ht & 1) * 32;
            const float* cp = MST + (rec0 + cdir) * MREC + ce * 64 + cd0;
            f32x4 cc[8];
#pragma unroll
            for (int q = 0; q < 8; ++q) cc[q] = *(const f32x4*)(cp + 4 * q);
            const float nsv = (ht < 128) ? MST[(rec0 + (ht >> 6)) * MREC + 4096 + (ht & 63)] : 0.f;
            const float miv = (ht < 2) ? MSC[(rec0 + ht) * 4 + 2] : 0.f;
            asm volatile("" ::: "memory");
            float tv[16];
#pragma unroll
            for (int ps = 0; ps < 2; ++ps) {
                ConvRaw rq1 = rq0, rk1 = rk0;
                if (ps) { asm volatile("" ::: "memory"); rq1 = conv16_load(U, row0 + s, U_Q + 64 * h + dq + 16, hasp, hasn); rk1 = conv16_load(U, row0 + s, U_K + 64 * h + dq + 16, hasp, hasn); }
                conv16_compute(rq1, cw, cb, 64 * h + dq + 16 * ps, 0.125f, tv);
                { u32x4 w0, w1; w0.x = pk2(tv[0], tv[1]); w0.y = pk2(tv[2], tv[3]); w0.z = pk2(tv[4], tv[5]); w0.w = pk2(tv[6], tv[7]); w1.x = pk2(tv[8], tv[9]); w1.y = pk2(tv[10], tv[11]); w1.z = pk2(tv[12], tv[13]); w1.w = pk2(tv[14], tv[15]);
                  *(LAS u32x4*)(Qs + s * QS + (dq + 16 * ps) * 2) = w0; *(LAS u32x4*)(Qs + s * QS + (dq + 16 * ps) * 2 + 16) = w1; }
                conv16_compute(rk1, cw, cb, 256 + 64 * h + dq + 16 * ps, 1.0f, tv);
                { u32x4 w0, w1; w0.x = pk2(tv[0], tv[1]); w0.y = pk2(tv[2], tv[3]); w0.z = pk2(tv[4], tv[5]); w0.w = pk2(tv[6], tv[7]); w1.x = pk2(tv[8], tv[9]); w1.y = pk2(tv[10], tv[11]); w1.z = pk2(tv[12], tv[13]); w1.w = pk2(tv[14], tv[15]);
                  *(LAS u32x4*)(Ks + s * QS + (dq + 16 * ps) * 2) = w0; *(LAS u32x4*)(Ks + s * QS + (dq + 16 * ps) * 2 + 16) = w1; }
            }
            const unsigned vu[16] = {v0.x, v0.y, v0.z, v0.w, v1.x, v1.y, v1.z, v1.w, v2.x, v2.y, v2.z, v2.w, v3.x, v3.y, v3.z, v3.w};
#pragma unroll
            for (int i = 0; i < 16; ++i) {
                *(LAS bf16_t*)(VTl + (dq + 2 * i) * RS + s * 2) = (bf16_t)(vu[i] & 0xffffu);
                *(LAS bf16_t*)(VTl + (dq + 2 * i + 1) * RS + s * 2) = (bf16_t)(vu[i] >> 16);
            }
#pragma unroll
            for (int q = 0; q < 4; ++q) {
                u32x4 w; w.x = pk2(cc[2 * q][0], cc[2 * q][1]); w.y = pk2(cc[2 * q][2], cc[2 * q][3]); w.z = pk2(cc[2 * q + 1][0], cc[2 * q + 1][1]); w.w = pk2(cc[2 * q + 1][2], cc[2 * q + 1][3]);
                *(LAS u32x4*)(Cs + (cdir * 64 + ce) * QS + (cd0 + 8 * q) * 2) = w;
            }
            if (ht < 128) ns[ht] = nsv;
            if (ht < 2) mi[ht] = miv;
        }
        __syncthreads();
        const int t = 32 * tb + r;
        bf16x8 qf[4];
#pragma unroll
        for (int ks = 0; ks < 4; ++ks) qf[ks] = *(const LAS bf16x8*)(Qs + t * QS + ks * 32 + hh * 16);
        f32x16 hs0, hs1;
#pragma unroll
        for (int i = 0; i < 16; ++i) { hs0[i] = 0.f; hs1[i] = 0.f; }
        u32x2 ogw[4][2];
        { const bf16_t* og = U + (row0 + t) * UW + U_O + 64 * h;
#pragma unroll
          for (int g = 0; g < 4; ++g)
#pragma unroll
              for (int eb = 0; eb < 2; ++eb) ogw[g][eb] = *(const u32x2*)(og + 32 * eb + 8 * g + 4 * hh); }
#pragma unroll
        for (int dir = 0; dir < 2; ++dir) {
            const float m_in = mi[dir];
            const float Mt = fmaxf(m_in, pmx[dir * 128 + t]);
            const float a_t = expf(m_in - Mt);
            f32x16 o0, o1;
#pragma unroll
            for (int i = 0; i < 16; ++i) { o0[i] = 0.f; o1[i] = 0.f; }
            float qn = 0.f;
#pragma unroll
            for (int ks = 0; ks < 4; ++ks) {
                const bf16x8 c0 = *(const LAS bf16x8*)(Cs + (dir * 64 + r) * QS + ks * 32 + hh * 16);
                const bf16x8 c1 = *(const LAS bf16x8*)(Cs + (dir * 64 + 32 + r) * QS + ks * 32 + hh * 16);
                o0 = MFMA32(c0, qf[ks], o0); o1 = MFMA32(c1, qf[ks], o1);
#pragma unroll
                for (int jx = 0; jx < 8; ++jx) qn += bf2f((bf16_t)qf[ks][jx]) * ns[dir * 64 + ks * 16 + hh * 8 + jx];
            }
            qn = xor32_sum(qn);
#pragma unroll
            for (int i = 0; i < 16; ++i) { o0[i] *= a_t; o1[i] *= a_t; }
            float rs = 0.f;
            const int sb_lo = dir ? tb : 0, sb_hi = dir ? 3 : tb;
            for (int sb = sb_lo; sb <= sb_hi; ++sb) {
                f32x16 sv;
#pragma unroll
                for (int i = 0; i < 16; ++i) sv[i] = 0.f;
#pragma unroll
                for (int ks = 0; ks < 4; ++ks) {
                    const bf16x8 ka = *(const LAS bf16x8*)(Ks + (32 * sb + r) * QS + ks * 32 + hh * 16);
                    sv = MFMA32(ka, qf[ks], sv);
                }
#pragma unroll
                for (int i = 0; i < 16; ++i) {
                    const int sx = 32 * sb + crow(i, hh);
                    const bool valid = dir ? (sx >= t) : (sx <= t);
                    const float wgt = valid ? expf(gg[dir * 128 + sx] - Mt) : 0.f;
                    sv[i] *= wgt; rs += sv[i];
                }
#pragma unroll
                for (int ss = 0; ss < 2; ++ss) {
                    u32x4 pw; pw.x = pk2(sv[8 * ss], sv[8 * ss + 1]); pw.y = pk2(sv[8 * ss + 2], sv[8 * ss + 3]); pw.z = pk2(sv[8 * ss + 4], sv[8 * ss + 5]); pw.w = pk2(sv[8 * ss + 6], sv[8 * ss + 7]);
                    const bf16x8 pf = __builtin_bit_cast(bf16x8, pw);
                    const int koff = (32 * sb + 16 * ss + 4 * hh) * 2;
                    const s16x4 va0 = *(const LAS s16x4*)(VTl + r * RS + koff), va1 = *(const LAS s16x4*)(VTl + r * RS + koff + 16);
                    const s16x4 vb0 = *(const LAS s16x4*)(VTl + (32 + r) * RS + koff), vb1 = *(const LAS s16x4*)(VTl + (32 + r) * RS + koff + 16);
                    o0 = MFMA32(__builtin_shufflevector(va0, va1, 0, 1, 2, 3, 4, 5, 6, 7), pf, o0);
                    o1 = MFMA32(__builtin_shufflevector(vb0, vb1, 0, 1, 2, 3, 4, 5, 6, 7), pf, o1);
                }
            }
            rs = xor32_sum(rs);
            const float den = a_t * qn + rs, mt = bcum[dir * 128 + t] + Mt;
            const float dd = 1.0f / fmaxf(fabsf(den), expf(-mt));
#pragma unroll
            for (int i = 0; i < 16; ++i) { hs0[i] += o0[i] * dd; hs1[i] += o1[i] * dd; }
        }
        {
            float ssq = 0.f;
#pragma unroll
            for (int i = 0; i < 16; ++i) ssq += hs0[i] * hs0[i] + hs1[i] * hs1[i];
            ssq = xor32_sum(ssq);
            const float rstd = rsqrtf(ssq * (1.0f / 64.0f) + EPS);
            const float* gn = a.m_norm_g + (size_t)l * 256 + 64 * h;
            bf16_t* op = MIX + (row0 + t) * 1024 + 256 + 64 * h;
#pragma unroll
            for (int g = 0; g < 4; ++g) {
#pragma unroll
                for (int eb = 0; eb < 2; ++eb) {
                    const int e0 = 32 * eb + 8 * g + 4 * hh;
                    const u32x2 ow = ogw[g][eb];
                    const float og0 = __uint_as_float(ow.x << 16), og1 = __uint_as_float(ow.x & 0xffff0000u), og2 = __uint_as_float(ow.y << 16), og3 = __uint_as_float(ow.y & 0xffff0000u);
                    const float h0 = (eb ? hs1[4 * g] : hs0[4 * g]), h1 = (eb ? hs1[4 * g + 1] : hs0[4 * g + 1]), h2 = (eb ? hs1[4 * g + 2] : hs0[4 * g + 2]), h3 = (eb ? hs1[4 * g + 3] : hs0[4 * g + 3]);
                    u32x2 w; w.x = pk2(h0 * rstd * gn[e0] * sigmoid_f(og0), h1 * rstd * gn[e0 + 1] * sigmoid_f(og1));
                    w.y = pk2(h2 * rstd * gn[e0 + 2] * sigmoid_f(og2), h3 * rstd * gn[e0 + 3] * sigmoid_f(og3));
                    *(u32x2*)(op + e0) = w;
                }
            }
        }
        __syncthreads();
    }
}
DI void phase_fft_a(const Args& a, LAS unsigned char* lds) {
    const int tid = tidx(), lane = tid & 63, wid = tid >> 6, r = lane & 31, hh = lane >> 5;
    constexpr int RS = 272;
    LAS unsigned char* WAs = lds;
    LAS unsigned char* Fs = lds + 256 * RS;
    const bf16_t* WA = (const bf16_t*)(a.ws + WS_WA);
    for (int i = tid; i < 256 * 16; i += NTHR) { const int m = i >> 4, ch = i & 15; *(LAS u32x4*)(WAs + m * RS + ch * 16) = *(const u32x4*)(WA + m * 128 + ch * 8); }
    const bf16_t* U = (const bf16_t*)(a.ws + WS_R1); unsigned* FI = (unsigned*)(a.ws + WS_R4 + R4_FFTI);
    const f32x2* TW = (const f32x2*)(a.ws + WS_TW);
    for (int un = bidx(); un < NB * 64; un += gdim()) {
        const int b = un >> 6, cq = un & 63;
        __syncthreads();
        u32x2 wst[16];
#pragma unroll
        for (int i = 0; i < 16; ++i) { const int t = tid + NTHR * i; wst[i] = *(const u32x2*)(U + ((size_t)b * TPB + CTXL + t) * UW + U_F + 4 * cq); }
#pragma unroll
        for (int i = 0; i < 16; ++i) {
            const int t = tid + NTHR * i, t1 = t >> 6, t2 = t & 63;
            const u32x2 w = wst[i];
            *(LAS bf16_t*)(Fs + (0 * 64 + t2) * RS + t1 * 2) = (bf16_t)(w.x & 0xffffu);
            *(LAS bf16_t*)(Fs + (1 * 64 + t2) * RS + t1 * 2) = (bf16_t)(w.x >> 16);
            *(LAS bf16_t*)(Fs + (2 * 64 + t2) * RS + t1 * 2) = (bf16_t)(w.y & 0xffffu);
            *(LAS bf16_t*)(Fs + (3 * 64 + t2) * RS + t1 * 2) = (bf16_t)(w.y >> 16);
        }
        __syncthreads();
        const int c = wid >> 1, t2 = 32 * (wid & 1) + r;
        bf16x8 bfr[8];
#pragma unroll
        for (int ks = 0; ks < 8; ++ks) bfr[ks] = *(const LAS bf16x8*)(Fs + (c * 64 + t2) * RS + ks * 32 + hh * 16);
        for (int kb = 0; kb < 4; ++kb) {
            f32x16 re, im;
#pragma unroll
            for (int i = 0; i < 16; ++i) { re[i] = 0.f; im[i] = 0.f; }
#pragma unroll
            for (int ks = 0; ks < 8; ++ks) {
                const bf16x8 ar = *(const LAS bf16x8*)(WAs + (32 * kb + r) * RS + ks * 32 + hh * 16);
                const bf16x8 ai = *(const LAS bf16x8*)(WAs + (128 + 32 * kb + r) * RS + ks * 32 + hh * 16);
                re = MFMA32(ar, bfr[ks], re); im = MFMA32(ai, bfr[ks], im);
            }
#pragma unroll
            for (int i = 0; i < 16; ++i) {
                const int k1 = 32 * kb + crow(i, hh);
                const f32x2 cs = TW[(k1 * t2) & 8191];
                const float ore = re[i] * cs.x + im[i] * cs.y, oim = im[i] * cs.x - re[i] * cs.y;
                FI[((size_t)(b * 128 + k1) * 256 + 4 * cq + c) * 64 + t2] = pk2(ore, oim);
            }
        }
    }
    __syncthreads();
}

DI void phase_fft_bc(const Args& a, LAS unsigned char* lds, int nheavy = 0, int heavy_idx = -1, int light_idx = -1) {
    const int tid = tidx(), lane = tid & 63, wid = tid >> 6, r = lane & 31, hh = lane >> 5;
    constexpr int RS = 272, GS = 528;
    LAS unsigned char* WBs = lds;
    LAS unsigned char* WCs = lds + 128 * RS;
    LAS unsigned char* Gs = WCs + 64 * RS;
    const bf16_t* WB = (const bf16_t*)(a.ws + WS_WB); const bf16_t* WC = (const bf16_t*)(a.ws + WS_WC);
    for (int i = tid; i < 128 * 16; i += NTHR) { const int m = i >> 4, ch = i & 15; *(LAS u32x4*)(WBs + m * RS + ch * 16) = *(const u32x4*)(WB + m * 128 + ch * 8); }
    for (int i = tid; i < 64 * 16; i += NTHR) { const int m = i >> 4, ch = i & 15; *(LAS u32x4*)(WCs + m * RS + ch * 16) = *(const u32x4*)(WC + m * 128 + ch * 8); }
    const bf16_t* FI = (const bf16_t*)(a.ws + WS_R4 + R4_FFTI); bf16_t* MIX = (bf16_t*)(a.ws + WS_XN);
    const float oscale = 0.001381067932004976f;
    const int nlight = gdim() - nheavy, nreg = (nheavy > 0) ? (NB * 128 - nheavy) : NB * 128;
    int un = (nheavy > 0) ? ((heavy_idx >= 0) ? nreg + heavy_idx : light_idx) : bidx();
    const int ustep = (nheavy > 0) ? nlight : gdim(), ulim = (nheavy > 0 && heavy_idx >= 0) ? NB * 128 : nreg;
    for (; un < ulim; un += (nheavy > 0 && heavy_idx >= 0) ? NB * 128 : ustep) {
        const int b = un >> 7, k1 = un & 127;
        __syncthreads();
        {
            const int c = 32 * wid + r;
            const bf16_t* ip = FI + ((size_t)(b * 128 + k1) * 256 + c) * 128 + 8 * hh;
            bf16x8 bfr[8];
#pragma unroll
            for (int ks = 0; ks < 8; ++ks) bfr[ks] = *(const bf16x8*)(ip + 16 * ks);
            for (int mb = 0; mb < 4; ++mb) {
                f32x16 acc;
#pragma unroll
                for (int i = 0; i < 16; ++i) acc[i] = 0.f;
#pragma unroll
                for (int ks = 0; ks < 8; ++ks) {
                    const bf16x8 aw = *(const LAS bf16x8*)(WBs + (32 * mb + r) * RS + ks * 32 + hh * 16);
                    acc = MFMA32(aw, bfr[ks], acc);
                }
#pragma unroll
                for (int i = 0; i < 16; ++i) *(LAS bf16_t*)(Gs + (32 * mb + crow(i, hh)) * GS + c * 2) = f2bf(acc[i]);
            }
        }
        __syncthreads();
        {
            const int g = wid >> 1, lb = wid & 1;
            bf16x8 wf[8];
#pragma unroll
            for (int ks = 0; ks < 8; ++ks) wf[ks] = *(const LAS bf16x8*)(WCs + (32 * lb + r) * RS + ks * 32 + hh * 16);
            for (int kb2 = 0; kb2 < 2; ++kb2) {
                f32x16 acc;
#pragma unroll
                for (int i = 0; i < 16; ++i) acc[i] = 0.f;
#pragma unroll
                for (int ks = 0; ks < 8; ++ks) {
                    const int ri = ks >> 2;
                    const bf16x8 ag = *(const LAS bf16x8*)(Gs + (ri * 64 + 32 * kb2 + r) * GS + (g * 64 + 16 * (ks & 3) + 8 * hh) * 2);
                    acc = MFMA32(ag, wf[ks], acc);
                }
#pragma unroll
                for (int i = 0; i < 16; ++i) {
                    const int k2 = 32 * kb2 + crow(i, hh);
                    MIX[((size_t)b * TPB + CTXL + k1 + 128 * k2) * 1024 + g * 64 + 32 * lb + r] = f2bf(acc[i] * oscale);
                }
            }
        }
    }
    __syncthreads();
}

DI void phase_cfft(const Args& a, LAS unsigned char* lds) {
    const int tid = tidx();
    const bf16_t* U = (const bf16_t*)(a.ws + WS_R1); const f32x2* TW = (const f32x2*)(a.ws + WS_TW); bf16_t* MIX = (bf16_t*)(a.ws + WS_XN);
    LAS f32x2* tw = (LAS f32x2*)lds;
    LAS f32x2* T = tw + 256;
    LAS unsigned char* Fs = lds + 2048 + 16384;
    LAS f32x2* Gs = (LAS f32x2*)Fs;
    __syncthreads();
    if (tid < 256) tw[tid] = TW[tid * 32];
    for (int un = bidx(); un < NB * 32; un += gdim()) {
        const int b = un >> 5, kb = 8 * (un & 31);
        __syncthreads();
        {
            u32x4 rr[16];
#pragma unroll
            for (int i = 0; i < 16; ++i) { const int ch = tid + 512 * i, t = ch >> 5, cc = (ch & 31) * 8; rr[i] = *(const u32x4*)(U + ((size_t)b * TPB + t) * UW + U_F + cc); }
#pragma unroll
            for (int i = 0; i < 4; ++i) { const int idx = tid + 512 * i, t = idx >> 3, q = idx & 7; T[idx] = tw[((kb + q) * t) & 255]; }
#pragma unroll
            for (int i = 0; i < 16; ++i) { const int ch = tid + 512 * i, t = ch >> 5, cc = (ch & 31) * 8; *(LAS u32x4*)(Fs + t * 512 + cc * 2) = rr[i]; }
        }
        __syncthreads();
        const int kh = tid >> 8, c = tid & 255;
        float gr[4] = {0.f, 0.f, 0.f, 0.f}, gi[4] = {0.f, 0.f, 0.f, 0.f};
#pragma unroll 8
        for (int t = 0; t < 256; ++t) {
            const float f = bf2f(*(const LAS bf16_t*)(Fs + t * 512 + c * 2));
            const f32x4 t01 = *(const LAS f32x4*)(T + t * 8 + 4 * kh), t23 = *(const LAS f32x4*)(T + t * 8 + 4 * kh + 2);
            gr[0] += f * t01[0]; gi[0] -= f * t01[1]; gr[1] += f * t01[2]; gi[1] -= f * t01[3];
            gr[2] += f * t23[0]; gi[2] -= f * t23[1]; gr[3] += f * t23[2]; gi[3] -= f * t23[3];
        }
        __syncthreads();
#pragma unroll
        for (int q = 0; q < 4; ++q) Gs[(4 * kh + q) * 256 + c] = (f32x2){gr[q], gi[q]};
        __syncthreads();
        const int g = (tid >> 6) & 3, lx = tid & 63;
        float y[4] = {0.f, 0.f, 0.f, 0.f};
#pragma unroll 8
        for (int c2 = 0; c2 < 64; ++c2) {
            const f32x2 cs = tw[((lx * c2) & 63) * 4];
#pragma unroll
            for (int q = 0; q < 4; ++q) { const f32x2 gv = Gs[(4 * kh + q) * 256 + 64 * g + c2]; y[q] += cs.x * gv.x + cs.y * gv.y; }
        }
#pragma unroll
        for (int q = 0; q < 4; ++q) MIX[((size_t)b * TPB + kb + 4 * kh + q) * 1024 + 64 * g + lx] = f2bf(y[q] * (1.0f / 128.0f));
    }
    __syncthreads();
}

DI void phase_krope(const Args& a) {
    const bf16_t* U = (const bf16_t*)(a.ws + WS_R1); bf16_t* KR = (bf16_t*)(a.ws + WS_R2 + R2_KR); const f32x2* RP = (const f32x2*)(a.ws + WS_ROPE);
    for (int gid = bidx() * NTHR + tidx(); gid < NROW * 16; gid += gdim() * NTHR) {
        const int row = gid >> 4, i = gid & 15, pos = row % TPB;
        const unsigned w = *(const unsigned*)(U + (size_t)row * UW + U_KR + 2 * i);
        float t1 = __uint_as_float(w << 16), t2 = __uint_as_float(w & 0xffff0000u);
        if (pos >= CTXL) {
            const int tp = pos - CTXL, rr = tp >> 6, cc = tp & 63;
            const f32x2 cs = (i < 8) ? RP[rr * 8 + i] : RP[1024 + cc * 8 + (i - 8)];
            const float o1 = t1 * cs.x - t2 * cs.y, o2 = t1 * cs.y + t2 * cs.x; t1 = o1; t2 = o2;
        }
        *(unsigned*)(KR + (size_t)row * 32 + 2 * i) = pk2(t1, t2);
    }
}

DI void phase_kmax(const Args& a, LAS unsigned char* lds) {
    const int tid = tidx(), lane = tid & 63;
    const bf16_t* KN = (const bf16_t*)(a.ws + WS_R2 + R2_KN); const bf16_t* KR = (const bf16_t*)(a.ws + WS_R2 + R2_KR);
    unsigned* KMAX = (unsigned*)(a.ws + WS_R4 + R4_KMAX);
    LAS unsigned* lm = (LAS unsigned*)lds;
    const int rpb = (NROW + gdim() - 1) / gdim(), row_lo = bidx() * rpb, row_hi = (row_lo + rpb < NROW) ? row_lo + rpb : NROW;
    __syncthreads();
    if (tid < 9) lm[tid] = 0u;
    __syncthreads();
    const int b0 = row_lo / TPB;
    for (int it = tid; it < (row_hi - row_lo) * 8; it += NTHR) {
        const int row = row_lo + (it >> 3), h = it & 7, b = row / TPB;
        const u32x4* kp = (const u32x4*)(KN + (size_t)row * 512 + h * 64);
        float ss = 0.f;
#pragma unroll
        for (int q = 0; q < 8; ++q) { const u32x4 w = kp[q]; const unsigned wu[4] = {w.x, w.y, w.z, w.w};
#pragma unroll
            for (int j = 0; j < 4; ++j) { const float lo = __uint_as_float(wu[j] << 16), hi = __uint_as_float(wu[j] & 0xffff0000u); ss += lo * lo + hi * hi; } }
        float sr = 0.f;
        if (h == 0) { const u32x4* rp = (const u32x4*)(KR + (size_t)row * 32);
#pragma unroll
            for (int q = 0; q < 4; ++q) { const u32x4 w = rp[q]; const unsigned wu[4] = {w.x, w.y, w.z, w.w};
#pragma unroll
                for (int j = 0; j < 4; ++j) { const float lo = __uint_as_float(wu[j] << 16), hi = __uint_as_float(wu[j] & 0xffff0000u); sr += lo * lo + hi * hi; } } }
        if (b == b0) { __hip_atomic_fetch_max(&lm[h], __float_as_uint(ss), __ATOMIC_RELAXED, __HIP_MEMORY_SCOPE_WORKGROUP); if (h == 0) __hip_atomic_fetch_max(&lm[8], __float_as_uint(sr), __ATOMIC_RELAXED, __HIP_MEMORY_SCOPE_WORKGROUP); }
        else { atomicMax(&KMAX[b * 8 + h], __float_as_uint(ss)); if (h == 0) atomicMax(&KMAX[64 + b], __float_as_uint(sr)); }
    }
    __syncthreads();
    if (tid < 8) atomicMax(&KMAX[b0 * 8 + tid], lm[tid]);
    if (tid == 8) atomicMax(&KMAX[64 + b0], lm[8]);
    __syncthreads();
    (void)lane;
}
#ifndef REPS_P6
#define REPS_P6 1
#endif
#ifndef REPS_P3G
#define REPS_P3G 1
#endif
#ifndef REPS_P2
#define REPS_P2 1
#endif
#ifndef REPS_P10
#define REPS_P10 1
#endif
#ifndef REPS_P11
#define REPS_P11 1
#endif
#ifndef REPS_P7
#define REPS_P7 1
#endif
#ifndef REPS_P8
#define REPS_P8 1
#endif
#ifndef REPS_P9
#define REPS_P9 1
#endif
constexpr int WP_R1 = 3480, WP_R2 = 7380, WP_R3 = 9712;
constexpr int N_PHASES = 1 + 10 * DEPTH + 1;
typedef const __attribute__((address_space(4))) Args CArgs;
DI LAS unsigned char* lds_base() { extern __shared__ __attribute__((aligned(16))) unsigned char smem_raw[]; LAS unsigned char* p = (LAS unsigned char*)smem_raw; return p; }
#define LOAD_ARGS CArgs* ap2_ = ap; asm volatile("" : "+s"(ap2_)); const Args a = *(const Args*)ap2_; LAS unsigned char* lds = lds_base();

__global__ void __launch_bounds__(NTHR, 2) mega_fwd(Args a_) {
    CArgs* ap = (CArgs*)__builtin_amdgcn_kernarg_segment_ptr();
    volatile LAS unsigned* xbw = (volatile LAS unsigned*)(lds_base() + LDS_BYTES - 16);
    if (threadIdx.x == 0) { xbw[0] = 0u; xbw[1] = 0u; xbw[2] = 0u; xbw[3] = 0u; }
    __syncthreads();
    const int ph_lo = ap->ph_lo, ph_hi = ap->ph_hi;
    const bool multi = (ph_hi - ph_lo) > 1;
    XcdBarrier bar; bar.bar = (unsigned*)(ap->ws + WS_BAR); bar.x = 0; bar.st = xbw;
    if (multi) bar = xcd_barrier_post((unsigned*)(ap->ws + WS_BAR), xbw);
    int ph = 0;
#define PH_BEGIN { int lo_ = ph_lo, hi_ = ph_hi; asm volatile("" : "+s"(lo_), "+s"(hi_)); if (ph >= lo_ && ph < hi_) {
#ifdef PROBE_BAR
#define PH_END   if (ph + 1 < hi_) { xcd_barrier(bar); xcd_barrier(bar); } } } ++ph;
#else
#define PH_END   if (ph + 1 < hi_) xcd_barrier(bar); } } ++ph;
#endif
    PH_BEGIN { LOAD_ARGS phase_prologue(a, lds); }
    { LOAD_ARGS phase_wprep(a, 0, lds); }
#ifdef PROBE_PRO
    { LOAD_ARGS phase_prologue(a, lds); }
#endif
    PH_END
    for (int l = 0; l < DEPTH; ++l) {
        PH_BEGIN
#ifdef PROBE_WPREP
            { LOAD_ARGS phase_wprep(a, l, lds); }
#endif
            { LOAD_ARGS if (l == 0) phase_norm1<true, false>(a, l, lds); else phase_norm1<false, false>(a, l, lds); }
#ifdef PROBE_P1
            { LOAD_ARGS if (l == 0) phase_norm1<true, false>(a, l, lds); else phase_norm1<false, false>(a, l, lds, 0.0f); }
#endif
        PH_END
        PH_BEGIN _Pragma("nounroll") for (int rep_ = 0; rep_ < REPS_P2; ++rep_) { LOAD_ARGS
            pg8::StaticOrder S; S.init(NROW, UW, gdim(), bidx());
            pg8::Gemm g{(const bf16_t*)(a.ws + WS_XN), (const bf16_t*)(a.ws + wsw(WS_WIN, l)), NROW, UW, 1024, 1024, 1024, 1 << 30, 0, nullptr, 0};
            EpiIn E{(bf16_t*)(a.ws + WS_R1), (float*)(a.ws + WS_R4 + R4_GATES), (float*)(a.ws + WS_R4 + R4_SSQ)};
            pg8::gemm_phase(lds, g, S, E); }
            if (l < DEPTH - 1) { LOAD_ARGS const int nex_ = ((NROW / 256) * (UW / 256)) % gdim(); if (bidx() >= nex_) phase_wprep(a, l + 1, lds, 0, WP_R1, bidx() - nex_, gdim() - nex_); }
        PH_END
        PH_BEGIN
            _Pragma("nounroll") for (int rep_ = 0; rep_ < REPS_P3G; ++rep_) {
            { LOAD_ARGS
              const bool lastl = (l == DEPTH - 1); pg8::StaticOrder S; S.init(lastl ? NB * SEQ : NROW, 768, gdim(), bidx());
              pg8::Gemm g{(const bf16_t*)(a.ws + WS_R1) + U_CQ, (const bf16_t*)(a.ws + wsw(WS_WQ, l)), NROW, 768, 384, UW, 384, 1 << 30, 0, nullptr, lastl ? 1 : 0};
              EpiQ E{(bf16_t*)(a.ws + WS_R2 + R2_Q), (const float*)(a.ws + WS_R4 + R4_SSQ)};
              pg8::gemm_phase(lds, g, S, E); }
            { LOAD_ARGS
              pg8::StaticOrder S; S.init(NROW, 1024, gdim(), (bidx() + 64) % gdim());
              pg8::Gemm g{(const bf16_t*)(a.ws + WS_R1) + U_CKV, (const bf16_t*)(a.ws + wsw(WS_WKV, l)), NROW, 1024, 256, UW, 256, 1 << 30, 0, nullptr, 0};
              EpiKV E{(bf16_t*)(a.ws + WS_R2 + R2_KN), (bf16_t*)(a.ws + WS_R2 + R2_VT), (const float*)(a.ws + WS_R4 + R4_SSQ)};
              pg8::gemm_phase(lds, g, S, E); }
            }
            { LOAD_ARGS phase_krope(a); }
#ifdef PROBE_KROPE
            { LOAD_ARGS phase_krope(a); }
#endif
            { LOAD_ARGS phase_fft_a(a, lds); }
#ifdef PROBE_FFTA
            { LOAD_ARGS phase_fft_a(a, lds); }
#endif
            { LOAD_ARGS phase_mlstm_local(a, l, lds); }
#ifdef PROBE_MLOC
            { LOAD_ARGS phase_mlstm_local(a, l, lds); }
#endif
            if (l < DEPTH - 1) { LOAD_ARGS phase_cfft(a, lds); }
#ifdef PROBE_CFFT
            if (l < DEPTH - 1) { LOAD_ARGS phase_cfft(a, lds); }
#endif
        PH_END
        PH_BEGIN
            { LOAD_ARGS phase_mlstm_scan(a); }
#ifdef PROBE_SCAN
            { LOAD_ARGS phase_mlstm_scan(a); }
#endif
            { LOAD_ARGS phase_kmax(a, lds); }
#ifdef PROBE_KMAX
            { LOAD_ARGS phase_kmax(a, lds); }
#endif
        PH_END
        PH_BEGIN
            { LOAD_ARGS phase_attention(a, l, lds); }
#ifdef PROBE_ATTN
            { LOAD_ARGS phase_attention(a, l, lds); }
#endif
            { LOAD_ARGS phase_mlstm_out2(a, l, lds); }
#ifdef PROBE_MOUT
            { LOAD_ARGS phase_mlstm_out2(a, l, lds); }
#endif
            {
                LOAD_ARGS
                const int npair = ((l < DEPTH - 1) ? NB * 4 * NCHUNK : NB * 4 * (NCHUNK - 2)) / 2, nheavy = (gdim() == 256) ? npair % 256 : 0;
                const int p0 = (bidx() + 128) % gdim();
                int hv = -1, lt = -1; if (nheavy > 0) { if (p0 < nheavy) hv = p0; else lt = p0 - nheavy; }
                phase_fft_bc(a, lds, nheavy, hv, lt);
            }
#ifdef PROBE_FFTBC
            { LOAD_ARGS phase_fft_bc(a, lds); }
#endif
        PH_END
        PH_BEGIN _Pragma("nounroll") for (int rep_ = 0; rep_ < REPS_P6; ++rep_) { LOAD_ARGS
            const bool lastl = (l == DEPTH - 1); pg8::StaticOrder S; S.init(lastl ? NB * SEQ : NROW, 1024, gdim(), bidx());
            pg8::Gemm g{(const bf16_t*)(a.ws + WS_XN), (const bf16_t*)(a.ws + wsw(WS_WOUT, l)), NROW, 1024, 1024, 1024, 1024, 1 << 30, 0, nullptr, lastl ? 1 : 0};
            EpiOut E{(xres_t*)(a.ws + WS_X), (const float*)(a.ws + WS_MOD) + (size_t)l * 9 * 6144, rep_ == 0 ? 1.0f : 0.0f};
            pg8::gemm_phase(lds, g, S, E); }
            if (l < DEPTH - 1) { LOAD_ARGS const int nex_ = ((NROW / 256) * 4) % gdim(); if (bidx() >= nex_) phase_wprep(a, l + 1, lds, WP_R1, WP_R2, bidx() - nex_, gdim() - nex_); }
        PH_END
        PH_BEGIN _Pragma("nounroll") for (int rep_ = 0; rep_ < REPS_P7; ++rep_) { LOAD_ARGS phase_norm2_router(a, l, lds); } PH_END
        PH_BEGIN _Pragma("nounroll") for (int rep_ = 0; rep_ < REPS_P8; ++rep_) { LOAD_ARGS phase_topk(a, lds); } PH_END
        PH_BEGIN _Pragma("nounroll") for (int rep_ = 0; rep_ < REPS_P10; ++rep_) { LOAD_ARGS
            const bool lastl = (l == DEPTH - 1); pg8::StaticOrder S; S.init(lastl ? NEXP * NB * CAPX : NSLOT, 2048, gdim(), bidx());
            pg8::Gemm g{(const bf16_t*)(a.ws + WS_XN), (const bf16_t*)(a.ws + wsw(WS_WGU, l)), NSLOT, 2048, 1024, 1024, 1024, 33, (size_t)2048 * 1024, (const int*)(a.ws + WS_R4 + R4_SEL), lastl ? 2 : 0};
            EpiGU E{(bf16_t*)(a.ws + WS_R2)};
            pg8::gemm_phase(lds, g, S, E); }
            if (l < DEPTH - 1) { LOAD_ARGS const int nex_ = ((NSLOT / 256) * 8) % gdim(); if (bidx() >= nex_) phase_wprep(a, l + 1, lds, WP_R2, WP_R3, bidx() - nex_, gdim() - nex_); }
        PH_END
        PH_BEGIN _Pragma("nounroll") for (int rep_ = 0; rep_ < REPS_P11; ++rep_) { LOAD_ARGS
            const bool lastl = (l == DEPTH - 1); pg8::StaticOrder S; S.init(lastl ? NEXP * NB * CAPX : NSLOT, 1024, gdim(), bidx());
            pg8::Gemm g{(const bf16_t*)(a.ws + WS_R2), (const bf16_t*)(a.ws + wsw(WS_WDN, l)), NSLOT, 1024, 1024, 1024, 1024, 33, (size_t)1024 * 1024, nullptr, lastl ? 2 : 0};
            EpiDN E{(bf16_t*)(a.ws + WS_R1), (const float*)(a.ws + WS_R4 + R4_GATEV)};
            pg8::gemm_phase(lds, g, S, E); }
            if (l < DEPTH - 1) { LOAD_ARGS const int nex_ = ((NSLOT / 256) * 4) % gdim(); if (bidx() >= nex_) phase_wprep(a, l + 1, lds, WP_R3, WPREP_TILES, bidx() - nex_, gdim() - nex_); }
        PH_END
    }
    PH_BEGIN { LOAD_ARGS phase_norm1<false, true>(a, DEPTH, lds); } PH_END
#undef PH_BEGIN
#undef PH_END
    (void)a_;
}

#ifndef MK_SINGLE
#define MK_SINGLE 0
#endif
extern "C" void kernel_launch(void* const* d_in, const int* in_sizes, int n_in, void* d_out, int out_size, void* d_ws, size_t ws_size, hipStream_t stream) {
    static int grid = 0;
    if (grid == 0) {
        if (n_in != 24 || ws_size < WS_END) { fprintf(stderr, "kernel_launch: need 24 inputs and >= %zu bytes of workspace; got n_in %d, ws %zu; nothing launched\n", (size_t)WS_END, n_in, ws_size); grid = -1; return; }
        int dev = 0, cus = 0;
        if (hipGetDevice(&dev) != hipSuccess || hipDeviceGetAttribute(&cus, hipDeviceAttributeMultiprocessorCount, dev) != hipSuccess) { grid = -1; return; }
        if (hipFuncSetAttribute((const void*)mega_fwd, hipFuncAttributeMaxDynamicSharedMemorySize, LDS_BYTES) != hipSuccess) { fprintf(stderr, "kernel_launch: hipFuncSetAttribute failed\n"); grid = -1; return; }
        int per_cu = 0;
        if (hipOccupancyMaxActiveBlocksPerMultiprocessor(&per_cu, (const void*)mega_fwd, NTHR, LDS_BYTES) != hipSuccess || per_cu < 1) fprintf(stderr, "kernel_launch: occupancy query says %d\n", per_cu);
        (void)hipGetLastError();
        grid = cus;
    }
    if (grid < 0) return;
    (void)hipMemsetAsync((char*)d_ws + WS_BAR, 0, 16384, stream);
    Args a{};
    a.x = (const float*)d_in[0]; a.c = (const float*)d_in[1]; a.ctx = (const float*)d_in[2]; a.c_ctx = (const float*)d_in[3]; a.ada_w = (const float*)d_in[4]; a.ada_b = (const float*)d_in[5];
    a.norm1_g = (const float*)d_in[6]; a.norm2_g = (const float*)d_in[7]; a.w_in = (const float*)d_in[8]; a.m_conv_w = (const float*)d_in[9]; a.m_conv_b = (const float*)d_in[10];
    a.m_ib = (const float*)d_in[11]; a.m_fb = (const float*)d_in[12]; a.m_norm_g = (const float*)d_in[13]; a.a_qnorm_g = (const float*)d_in[14]; a.a_wq_up = (const float*)d_in[15];
    a.a_kvnorm_g = (const float*)d_in[16]; a.a_wkv_up = (const float*)d_in[17]; a.w_out = (const float*)d_in[18]; a.router_w = (const float*)d_in[19]; a.e_w_gate = (const float*)d_in[20];
    a.e_w_up = (const float*)d_in[21]; a.e_w_down = (const float*)d_in[22]; a.final_g = (const float*)d_in[23];
    a.out = (float*)d_out; a.ws = (unsigned char*)d_ws;
#if MK_SINGLE
    a.ph_lo = 0; a.ph_hi = N_PHASES;
    hipLaunchKernelGGL(mega_fwd, dim3(grid), dim3(NTHR), LDS_BYTES, stream, a);
#else
    for (int p = 0; p < N_PHASES; ++p) { a.ph_lo = p; a.ph_hi = p + 1; hipLaunchKernelGGL(mega_fwd, dim3(grid), dim3(NTHR), LDS_BYTES, stream, a); }
#endif
}
```

```cpp
#include <hip/hip_runtime.h>
#include <cstdio>
#include <cstdint>

#define DI __device__ __forceinline__
#define LAS __attribute__((address_space(3)))
typedef unsigned short bf16_t;
typedef short bf16x8 __attribute__((ext_vector_type(8)));
typedef short s16x4 __attribute__((ext_vector_type(4)));
typedef float f32x4 __attribute__((ext_vector_type(4)));
typedef float f32x16 __attribute__((ext_vector_type(16)));
typedef float f32x2 __attribute__((ext_vector_type(2)));
typedef unsigned u32x4 __attribute__((ext_vector_type(4)));
typedef unsigned u32x2 __attribute__((ext_vector_type(2)));

constexpr int NB = 8, SEQ = 8192, CTXL = 256, TPB = SEQ + CTXL  , NROW = NB * TPB  , DM = 1024, DEPTH = 4;
constexpr int UW = 2048;
constexpr int U_F = 0, U_Q = 256, U_K = 512, U_V = 768, U_O = 1024, U_CQ = 1280, U_CKV = 1664, U_KR = 1920, U_G = 1952;
constexpr int NEXP = 16, CAPX = 1024, CAPC = 32, EROWS = NB * CAPX + NB * CAPC  , NSLOT = NEXP * EROWS  ;
constexpr int NTHR = 512;
constexpr int LDS_BYTES = 163840;
constexpr float EPS = 1e-6f;
constexpr float QSCALE = 0.10206207261596575f * 1.4426950408889634f;
constexpr int NCHUNK = TPB / 128;
constexpr int MREC = 4160;

constexpr size_t al256(size_t x) { return (x + 255) & ~(size_t)255; }
constexpr size_t WS_BAR   = 0;
constexpr size_t WS_MOD   = 16384;
constexpr size_t WS_TW    = al256(WS_MOD + (size_t)DEPTH * 9 * 6144 * 4);
constexpr size_t WS_ROPE  = al256(WS_TW + 8192 * 8);
constexpr size_t WS_WA    = al256(WS_ROPE + 192 * 8 * 8);
constexpr size_t WS_WB    = al256(WS_WA + 256 * 128 * 2);
constexpr size_t WS_WC    = al256(WS_WB + 128 * 128 * 2);
constexpr size_t WS_WIN   = al256(WS_WC + 64 * 128 * 2);
constexpr size_t WS_WQ    = al256(WS_WIN + (size_t)2048 * 1024 * 2);
constexpr size_t WS_WKV   = al256(WS_WQ + (size_t)768 * 384 * 2);
constexpr size_t WS_WOUT  = al256(WS_WKV + (size_t)1024 * 256 * 2);
constexpr size_t WS_WGU   = al256(WS_WOUT + (size_t)1024 * 1024 * 2);
constexpr size_t WS_WDN   = al256(WS_WGU + (size_t)16 * 2048 * 1024 * 2);
constexpr size_t WS_X     = al256(WS_WDN + (size_t)16 * 1024 * 1024 * 2);
constexpr size_t WS_WALTB = al256(WS_X + (size_t)NROW * 1024 * 2);
constexpr size_t WS_MSTB  = al256(WS_WALTB + (WS_X - WS_WGU));
static_assert(WS_MSTB + (size_t)NB * 4 * NCHUNK * 2 * 4096 * 2 <= WS_X + (size_t)NROW * 1024 * 4, "second expert-weight set and carry-in states must fit behind the bf16 residual");
constexpr size_t WS_XN    = al256(WS_X + (size_t)NROW * 1024 * 4);
constexpr size_t WS_R1    = al256(WS_XN + (size_t)NROW * 1024 * 2);
constexpr size_t WS_R2    = al256(WS_R1 + (size_t)NROW * 2048 * 2);
constexpr size_t R2_Q     = 0;
constexpr size_t R2_KN    = al256(R2_Q + (size_t)NROW * 768 * 2);
constexpr size_t R2_VT    = al256(R2_KN + (size_t)NROW * 512 * 2);
constexpr size_t R2_KR    = al256(R2_VT + (size_t)NROW * 512 * 2);
constexpr size_t R2_END   = al256(R2_KR + (size_t)NROW * 32 * 2);
constexpr size_t R2_SIZE  = (size_t)NSLOT * 1024 * 2 > R2_END ? (size_t)NSLOT * 1024 * 2 : R2_END;
constexpr size_t WS_R4    = al256(WS_R2 + R2_SIZE);
constexpr size_t R4_FFTI  = 0;
constexpr size_t R4_AFF   = 0;
constexpr size_t R4_INV   = al256(R4_AFF + (size_t)NROW * 16 * 4);
constexpr size_t R4_SEL   = al256(R4_INV + (size_t)NROW * 16 * 4);
constexpr size_t R4_GATEV = al256(R4_SEL + (size_t)NSLOT * 4);
constexpr size_t R4_MST   = al256((size_t)8 * 128 * 256 * 64 * 4);
constexpr size_t R4_MSC   = al256(R4_MST + (size_t)NB * 4 * NCHUNK * 2 * MREC * 4);
constexpr size_t R4_GATES = al256(R4_MSC + (size_t)NB * 4 * NCHUNK * 2 * 16);
constexpr size_t R4_SSQ   = al256(R4_GATES + (size_t)NROW * 16 * 4);
constexpr size_t R4_KMAX  = al256(R4_SSQ + (size_t)NROW * 20 * 4);
constexpr size_t R4_END   = al256(R4_KMAX + 72 * 4);
constexpr size_t WS_WALTS = al256(WS_R4 + R4_END);
constexpr size_t WS_END   = al256(WS_WALTS + (WS_WGU - WS_WIN));
static_assert(WS_END <= (size_t)1241209088, "workspace map exceeds the guaranteed scratch size");

DI float bf2f(bf16_t b) { return __uint_as_float(((unsigned)b) << 16); }
DI bf16_t f2bf(float f) { unsigned u = __float_as_uint(f); u += 0x7FFFu + ((u >> 16) & 1u); return (bf16_t)(u >> 16); }
typedef __bf16 bf16x2_t __attribute__((ext_vector_type(2)));
DI unsigned pk2(float lo, float hi) { const f32x2 f = {lo, hi}; return __builtin_bit_cast(unsigned, __builtin_convertvector(f, bf16x2_t)); }
#ifndef X_F32
typedef bf16_t xres_t;
DI f32x4 ldx4(const xres_t* p) { const u32x2 w = *(const u32x2*)p; return (f32x4){__uint_as_float(w.x << 16), __uint_as_float(w.x & 0xffff0000u), __uint_as_float(w.y << 16), __uint_as_float(w.y & 0xffff0000u)}; }
DI void stx4(xres_t* p, f32x4 v) { u32x2 w; w.x = pk2(v[0], v[1]); w.y = pk2(v[2], v[3]); *(u32x2*)p = w; }
#else
typedef float xres_t;
DI f32x4 ldx4(const xres_t* p) { return *(const f32x4*)p; }
DI void stx4(xres_t* p, f32x4 v) { *(f32x4*)p = v; }
#endif
DI size_t wsw(size_t off, int l) { return (l & 1) ? (off < WS_WGU ? off - WS_WIN + WS_WALTS : off - WS_WGU + WS_WALTB) : off; }
DI f32x4 bf4(u32x2 w) { return (f32x4){__uint_as_float(w.x << 16), __uint_as_float(w.x & 0xffff0000u), __uint_as_float(w.y << 16), __uint_as_float(w.y & 0xffff0000u)}; }
DI float silu_f(float x) { return x * __builtin_amdgcn_rcpf(1.0f + __expf(-x)); }
DI float sigmoid_f(float x) { return __builtin_amdgcn_rcpf(1.0f + __expf(-x)); }
template <int CTRL> DI float dppf(float v) { return __int_as_float(__builtin_amdgcn_update_dpp(0, __float_as_int(v), CTRL, 0xF, 0xF, false)); }
DI float tsum32(float a_, float b_) { const u32x2 r = __builtin_amdgcn_permlane32_swap(__float_as_uint(a_), __float_as_uint(b_), false, false); return __uint_as_float(r.x) + __uint_as_float(r.y); }
DI float tsum16(float a_, float b_) { const u32x2 r = __builtin_amdgcn_permlane16_swap(__float_as_uint(a_), __float_as_uint(b_), false, false); return __uint_as_float(r.x) + __uint_as_float(r.y); }
DI float xor32_sum(float v) { return tsum32(v, v); }
DI float xor16_sum(float v) { return tsum16(v, v); }
DI float xor32_max(float v) { const u32x2 r = __builtin_amdgcn_permlane32_swap(__float_as_uint(v), __float_as_uint(v), false, false); return fmaxf(__uint_as_float(r.x), __uint_as_float(r.y)); }
DI float xor16_max(float v) { const u32x2 r = __builtin_amdgcn_permlane16_swap(__float_as_uint(v), __float_as_uint(v), false, false); return fmaxf(__uint_as_float(r.x), __uint_as_float(r.y)); }
DI float row_sum16(float v) { v += dppf<0xB1>(v); v += dppf<0x4E>(v); v += dppf<0x124>(v); v += dppf<0x128>(v); return v; }
DI float row_max16(float v) { v = fmaxf(v, dppf<0xB1>(v)); v = fmaxf(v, dppf<0x4E>(v)); v = fmaxf(v, dppf<0x124>(v)); v = fmaxf(v, dppf<0x128>(v)); return v; }
DI float wave_sum(float v) { return xor32_sum(xor16_sum(row_sum16(v))); }
DI float wave_max(float v) { return xor32_max(xor16_max(row_max16(v))); }
DI int tidx() { int t = threadIdx.x; asm volatile("" : "+v"(t)); return t; }
DI int bidx() { int t = blockIdx.x; asm volatile("" : "+s"(t)); return t; }
DI int gdim() { int t = gridDim.x; asm volatile("" : "+s"(t)); return t; }
DI float max3f(float a, float b, float c) { float r; asm("v_max3_f32 %0, %1, %2, %3" : "=v"(r) : "v"(a), "v"(b), "v"(c)); return r; }
#define MFMA32(a, b, c) __builtin_amdgcn_mfma_f32_32x32x16_bf16((a), (b), (c), 0, 0, 0)
DI int crow(int reg, int h) { return (reg & 3) + 8 * (reg >> 2) + 4 * h; }

#define XB_TMO      128
#define XB_XCNT(j)  (256  + 64 * (j))
#define XB_XSUB(j)  (1280 + 64 * (j))
#define XB_XGEN(j)  (2304 + 64 * (j))
#define XB_TOP      3328
#define XB_TOPGEN   3392
#define XCD_BAR_WORDS 3456
#define XB_SPIN_CAP (1u << 18)
DI unsigned xb_ld(unsigned* p)              { return __hip_atomic_load(p, __ATOMIC_RELAXED, __HIP_MEMORY_SCOPE_AGENT); }
DI unsigned xb_add(unsigned* p, unsigned v) { return __hip_atomic_fetch_add(p, v, __ATOMIC_RELAXED, __HIP_MEMORY_SCOPE_AGENT); }
DI unsigned xb_xcc_id() { return (unsigned)__builtin_amdgcn_s_getreg((3 << 11) | 20) & 0xFu; }
#define XB_SPIN(cond, bar) do { unsigned _sp = 0; while (cond) { __builtin_amdgcn_s_sleep(1); \
    if ((++_sp & 255u) == 0u) { if (xb_ld(&(bar)[XB_TMO])) break; if (_sp > XB_SPIN_CAP) { atomicAdd(&(bar)[XB_TMO], 1u); break; } } } } while (0)
struct XcdBarrier { unsigned* bar; unsigned x; volatile LAS unsigned* st; };
DI XcdBarrier xcd_barrier_post(unsigned* bar, volatile LAS unsigned* st) {
    XcdBarrier b; b.bar = bar; b.x = xb_xcc_id(); b.st = st;
    if (threadIdx.x == 0) (void)xb_add(&bar[XB_XCNT(b.x)], 1u);
    return b;
}
DI void xcd_barrier_complete(unsigned* bar, unsigned x, unsigned& nloc, unsigned& nx) {
    const unsigned G = gridDim.x * gridDim.y * gridDim.z;
    unsigned sum, cnt, mine, sp = 0u;
    for (;;) {
        sum = 0u; cnt = 0u; mine = 0u;
#pragma unroll
        for (unsigned j = 0; j < 16; ++j) { const unsigned c = xb_ld(&bar[XB_XCNT(j)]); sum += c; cnt += (c > 0u) ? 1u : 0u; mine = (j == x) ? c : mine; }
        if (sum == G) break;
        __builtin_amdgcn_s_sleep(1);
        if ((++sp & 255u) == 0u) { if (xb_ld(&bar[XB_TMO])) break; if (sp > XB_SPIN_CAP) { atomicAdd(&bar[XB_TMO], 1u); break; } }
    }
    nloc = mine > 0u ? mine : 1u; nx = cnt > 0u ? cnt : 1u;
}
DI void xcd_barrier(const XcdBarrier& b) {
    asm volatile("s_waitcnt vmcnt(0)" ::: "memory");
    __syncthreads();
    if (threadIdx.x == 0) {
        unsigned* bar = b.bar;
        __builtin_amdgcn_s_waitcnt(0);
        unsigned nloc = b.st[0], nx = b.st[1];
        if (nloc == 0u) { xcd_barrier_complete(bar, b.x, nloc, nx); b.st[0] = nloc; b.st[1] = nx; }
        const unsigned old = xb_add(&bar[XB_XSUB(b.x)], 1u);
        const unsigned gen = old / nloc;
        if (old + 1u == (gen + 1u) * nloc) {
            __builtin_amdgcn_fence(__ATOMIC_RELEASE, "agent");
            asm volatile("s_waitcnt vmcnt(0)" ::: "memory");
            const unsigned og = xb_add(&bar[XB_TOP], 1u);
            const unsigned tg = og / nx;
            if (og + 1u == (tg + 1u) * nx) xb_add(&bar[XB_TOPGEN], 1u);
            else XB_SPIN(xb_ld(&bar[XB_TOPGEN]) == tg, bar);
            __builtin_amdgcn_fence(__ATOMIC_ACQUIRE, "agent");
            xb_add(&bar[XB_XGEN(b.x)], 1u);
            asm volatile("s_waitcnt vmcnt(0)" ::: "memory");
        } else {
            XB_SPIN(xb_ld(&bar[XB_XGEN(b.x)]) == gen, bar);
            __builtin_amdgcn_fence(__ATOMIC_ACQUIRE, "agent");
            asm volatile("s_waitcnt vmcnt(0)" ::: "memory");
        }
    }
    __syncthreads();
}

struct Args {
    const float* x; const float* c; const float* ctx; const float* c_ctx; const float* ada_w; const float* ada_b; const float* norm1_g; const float* norm2_g;
    const float* w_in; const float* m_conv_w; const float* m_conv_b; const float* m_ib; const float* m_fb; const float* m_norm_g; const float* a_qnorm_g; const float* a_wq_up;
    const float* a_kvnorm_g; const float* a_wkv_up; const float* w_out; const float* router_w; const float* e_w_gate; const float* e_w_up; const float* e_w_down; const float* final_g;
    float* out; unsigned char* ws; int ph_lo, ph_hi;
};
#define MK_SINGLE 1
namespace pg8 {
constexpr int BM = 256, BK = 64, HALF = 128, HTB = HALF * BK * 2  , STAGE_BYTES = 8 * HTB, NXCD = 8, WGM = 8;
__host__ __device__ __forceinline__ int lds_byte(int r, int c) { const int st = (r >> 4) * 2 + (c >> 5), rr = r & 15, cc = c & 31, ob = rr * 64 + cc * 2; return st * 1024 + (ob ^ (((ob >> 9) & 1) << 5)); }
__host__ __device__ __forceinline__ void stage_rc(int b, int& R, int& C) { const int st = b / 1024, sb = b % 1024, swz = sb ^ (((sb >> 9) & 1) << 5); R = (st >> 1) * 16 + swz / 64; C = (st & 1) * 32 + (swz % 64) / 2; }
__host__ __device__ __forceinline__ int perm32(int rho) { const int n = rho >> 4, i = rho & 15; return 8 * (i >> 2) + 4 * n + (i & 3); }

struct Unit { int pm, pn; };
struct Gemm { const bf16_t* A; const bf16_t* Bt; int M, N, K, lda, ldb, grp_units; size_t grp_stride; const int* rowidx; int skip; };

struct StaticOrder {
    int nM, nN, nwg, G, c;
    __device__ void init(int M, int N, int G_, int c_) { nM = M / BM; nN = N / BM; nwg = nM * nN; G = G_; c = c_; }
    __device__ bool next(int i, Unit& u) const {
        const long L = (long)i * G + c; if (L >= nwg) return false;
        int wgid = (int)L; { const int q = nwg / NXCD, r = nwg % NXCD, xcd = wgid % NXCD, off = wgid / NXCD; wgid = (xcd < r ? xcd * (q + 1) : r * (q + 1) + (xcd - r) * q) + off; }
        const int nig = WGM * nN, gid = wgid / nig, fm = gid * WGM, gsz = (nM - fm) < WGM ? (nM - fm) : WGM;
        u.pm = fm + ((wgid % nig) % gsz); u.pn = (wgid % nig) / gsz; return true;
    }
};

template <class Epi>
__device__ __forceinline__ void gemm_phase(LAS unsigned char* lds, const Gemm g, const StaticOrder& S, const Epi& E) {
    const int tid = tidx(), wid = __builtin_amdgcn_readfirstlane(tid >> 6), lane = tid & 63, wr = wid >> 2, wc = wid & 3, fr = lane & 15, fq = lane >> 4;
    const int K = g.K, nt = K / BK;
    unsigned voffB[2]; int RA[2], CA[2];
#pragma unroll
    for (int i = 0; i < 2; ++i) { int R, C; stage_rc(tid * 16 + i * 8192, R, C); const int Rb = Epi::PERM ? ((R & ~31) + perm32(R & 31)) : R;
        RA[i] = R; CA[i] = C; voffB[i] = (unsigned)(Rb * g.ldb + C) * 2u; }
#define PG8_AOFF(dst, pm_) do { _Pragma("unroll") for (int h_ = 0; h_ < 2; ++h_) _Pragma("unroll") for (int i_ = 0; i_ < 2; ++i_) { \
        const int r_ = (pm_) * BM + h_ * HALF + RA[i_]; const int rr_ = g.rowidx ? g.rowidx[r_] : r_; \
        dst[h_][i_] = (unsigned)rr_ * (unsigned)(g.lda * 2) + (unsigned)(CA[i_] * 2); } } while (0)
    const size_t kstep = (size_t)(BK * 2);
    const size_t hstepB = (size_t)HALF * g.ldb * 2;
    const size_t tstepB = 2 * hstepB;
    const unsigned ldsw = (unsigned)wid * 1024u;
    const int aoff = lds_byte(wr * 64 + fr, fq * 8), boff = lds_byte(wc * 32 + fr, fq * 8);
#define PG8_SA(b, h) (((b) * 2 + (h)) * HTB)
#define PG8_SB(b, h) ((4 + (b) * 2 + (h)) * HTB)
#define PG8_STAGE(bufoff, gbase, voff) do { _Pragma("unroll") for (int _i = 0; _i < 2; ++_i) \
        __builtin_amdgcn_global_load_lds((const unsigned*)((const char*)(gbase) + (voff)[_i]), (LAS unsigned*)(lds + (bufoff) + ldsw + _i * 8192), 16, 0, 0); } while (0)
#define PG8_LDA(dst, b, h) do { _Pragma("unroll") for (int m = 0; m < 4; ++m) _Pragma("unroll") for (int k = 0; k < 2; ++k) dst[m][k] = *(const LAS bf16x8*)(lds + PG8_SA(b, h) + aoff + m * 2048 + k * 1024); } while (0)
#define PG8_LDB(dst, b, h) do { _Pragma("unroll") for (int n = 0; n < 2; ++n) _Pragma("unroll") for (int k = 0; k < 2; ++k) dst[n][k] = *(const LAS bf16x8*)(lds + PG8_SB(b, h) + boff + n * 2048 + k * 1024); } while (0)
#define PG8_MMA(ai, bj, At, Bt) do { __builtin_amdgcn_s_setprio(1); _Pragma("unroll") for (int m = 0; m < 4; ++m) _Pragma("unroll") for (int n = 0; n < 2; ++n) _Pragma("unroll") for (int k = 0; k < 2; ++k) \
        acc[ai][bj][m][n] = __builtin_amdgcn_mfma_f32_16x16x32_bf16(Bt[n][k], At[m][k], acc[ai][bj][m][n], 0, 0, 0); __builtin_amdgcn_s_setprio(0); } while (0)
#define PG8_WAIT_V(n) asm volatile("s_waitcnt vmcnt(" #n ")" ::: "memory")
#define PG8_WAIT_L(n) asm volatile("s_waitcnt lgkmcnt(" #n ")" ::: "memory")
#define PG8_BAR __builtin_amdgcn_s_barrier()
#define PG8_SCHED __builtin_amdgcn_sched_barrier(0)
    Unit cur, nxt; int ui = 0;
    if (!S.next(0, cur)) return;
    if (g.skip) cur.pm = cur.pm + cur.pm / 32 + (g.skip == 1 ? 1 : 0);
    f32x4 acc[2][2][4][2];
#pragma unroll
    for (int a = 0; a < 2; ++a)
#pragma unroll
        for (int b = 0; b < 2; ++b)
#pragma unroll
            for (int m = 0; m < 4; ++m)
#pragma unroll
                for (int n = 0; n < 2; ++n) acc[a][b][m][n] = (f32x4){0.f, 0.f, 0.f, 0.f};
    bf16x8 At[4][2], B0[2][2], B1[2][2];
    unsigned curA[2][2], nxtA[2][2];
    PG8_AOFF(curA, cur.pm);
    const char* gA = (const char*)g.A;
    const char* cB = (const char*)g.Bt + ((size_t)(cur.pm / g.grp_units) * g.grp_stride) * 2 + (size_t)cur.pn * tstepB;
    PG8_STAGE(PG8_SB(0, 0), cB, voffB); PG8_STAGE(PG8_SA(0, 0), gA, curA[0]); PG8_STAGE(PG8_SB(0, 1), cB + hstepB, voffB); PG8_STAGE(PG8_SA(0, 1), gA, curA[1]);
    if (wr == 1) PG8_BAR;
    PG8_WAIT_V(4); PG8_BAR;
    PG8_STAGE(PG8_SB(1, 0), cB + kstep, voffB); PG8_STAGE(PG8_SA(1, 0), gA + kstep, curA[0]); PG8_STAGE(PG8_SB(1, 1), cB + hstepB + kstep, voffB);
    PG8_WAIT_V(6); PG8_BAR;
    for (;;) {
        const bool has_next = S.next(ui + 1, nxt);
        if (has_next && g.skip) nxt.pm = nxt.pm + nxt.pm / 32 + (g.skip == 1 ? 1 : 0);
        if (has_next) PG8_AOFF(nxtA, nxt.pm);
        else { _Pragma("unroll") for (int h_ = 0; h_ < 2; ++h_) _Pragma("unroll") for (int i_ = 0; i_ < 2; ++i_) nxtA[h_][i_] = curA[h_][i_]; }
        const char* nB = has_next ? (const char*)g.Bt + ((size_t)(nxt.pm / g.grp_units) * g.grp_stride) * 2 + (size_t)nxt.pn * tstepB : cB;
#pragma nounroll
        for (int t = 0; t < nt; t += 2) {
            const bool last = (t == nt - 2);
            const char* a1 = gA + (size_t)(t + 1) * kstep;
            const char* a2 = last ? gA : gA + (size_t)(t + 2) * kstep; const char* b2 = last ? nB : cB + (size_t)(t + 2) * kstep;
            const char* a3 = a2 + kstep; const char* b3 = b2 + kstep;
            unsigned oA0[2], oA1[2];
            oA0[0] = last ? nxtA[0][0] : curA[0][0]; oA0[1] = last ? nxtA[0][1] : curA[0][1]; oA1[0] = last ? nxtA[1][0] : curA[1][0]; oA1[1] = last ? nxtA[1][1] : curA[1][1];
            PG8_LDB(B0, 0, 0); PG8_SCHED; PG8_LDA(At, 0, 0); PG8_STAGE(PG8_SA(1, 1), a1, curA[1]);
            PG8_WAIT_L(8); PG8_BAR; PG8_WAIT_L(0); PG8_MMA(0, 0, At, B0); PG8_BAR; PG8_SCHED;
            PG8_LDB(B1, 0, 1); PG8_STAGE(PG8_SB(0, 0), b2, voffB);
            PG8_BAR; PG8_WAIT_L(0); PG8_MMA(0, 1, At, B1); PG8_BAR;
            PG8_LDA(At, 0, 1); PG8_STAGE(PG8_SA(0, 0), a2, oA0);
            PG8_BAR; PG8_WAIT_L(0); PG8_MMA(1, 0, At, B0); PG8_BAR; PG8_SCHED;
            PG8_STAGE(PG8_SB(0, 1), b2 + hstepB, voffB);
            PG8_WAIT_V(6); PG8_BAR; PG8_MMA(1, 1, At, B1); PG8_BAR;
            PG8_LDB(B0, 1, 0); PG8_SCHED; PG8_LDA(At, 1, 0); PG8_STAGE(PG8_SA(0, 1), a2, oA1);
            PG8_WAIT_L(8); PG8_BAR; PG8_WAIT_L(0); PG8_MMA(0, 0, At, B0); PG8_BAR; PG8_SCHED;
            PG8_LDB(B1, 1, 1); PG8_STAGE(PG8_SB(1, 0), b3, voffB);
            PG8_BAR; PG8_WAIT_L(0); PG8_MMA(0, 1, At, B1); PG8_BAR;
            PG8_LDA(At, 1, 1); PG8_STAGE(PG8_SA(1, 0), a3, oA0);
            PG8_BAR; PG8_WAIT_L(0); PG8_MMA(1, 0, At, B0); PG8_BAR; PG8_SCHED;
            PG8_STAGE(PG8_SB(1, 1), b3 + hstepB, voffB);
            PG8_WAIT_V(6); PG8_BAR; PG8_MMA(1, 1, At, B1); PG8_BAR;
        }
        E(acc, cur, wr, wc, fr, fq);
        if (!has_next) break;
#pragma unroll
        for (int a = 0; a < 2; ++a)
#pragma unroll
            for (int b = 0; b < 2; ++b)
#pragma unroll
                for (int m = 0; m < 4; ++m)
#pragma unroll
                    for (int n = 0; n < 2; ++n) acc[a][b][m][n] = (f32x4){0.f, 0.f, 0.f, 0.f};
        cur = nxt; cB = nB; ++ui;
#pragma unroll
        for (int h_ = 0; h_ < 2; ++h_)
#pragma unroll
            for (int i_ = 0; i_ < 2; ++i_) curA[h_][i_] = nxtA[h_][i_];
    }
    PG8_WAIT_V(0);
    if (wr == 0) PG8_BAR;
    PG8_BAR;
#undef PG8_AOFF
#undef PG8_SA
#undef PG8_SB
#undef PG8_STAGE
#undef PG8_LDA
#undef PG8_LDB
#undef PG8_MMA
#undef PG8_WAIT_V
#undef PG8_WAIT_L
#undef PG8_BAR
#undef PG8_SCHED
}
}
using pg8::Unit;
typedef f32x4 AccT[2][2][4][2];

struct EpiIn {
    static constexpr bool PERM = true;
    bf16_t* U; float* gates; float* ssq;
    DI void operator()(const AccT& acc, const Unit& u, int wr, int wc, int fr, int fq) const {
        const int row0 = u.pm * 256 + wr * 64 + fr, col0 = u.pn * 256 + wc * 32 + 8 * fq;
#pragma unroll
        for (int ai = 0; ai < 2; ++ai)
#pragma unroll
            for (int m = 0; m < 4; ++m) {
                const int row = row0 + ai * 128 + m * 16;
#pragma unroll
                for (int bj = 0; bj < 2; ++bj) {
                    const f32x4 v0 = acc[ai][bj][m][0], v1 = acc[ai][bj][m][1];
                    u32x4 w; w.x = pk2(v0[0], v0[1]); w.y = pk2(v0[2], v0[3]); w.z = pk2(v1[0], v1[1]); w.w = pk2(v1[2], v1[3]);
                    *(u32x4*)(U + (size_t)row * UW + col0 + bj * 128) = w;
                    int slot = -1;
                    if (u.pn == 5) slot = bj * 4 + wc; else if (u.pn == 6) slot = (bj == 0 ? 8 : 12) + wc; else if (u.pn == 7 && bj == 0) slot = 16 + wc;
                    if (slot >= 0) {
                        float s = v0[0] * v0[0] + v0[1] * v0[1] + v0[2] * v0[2] + v0[3] * v0[3] + v1[0] * v1[0] + v1[1] * v1[1] + v1[2] * v1[2] + v1[3] * v1[3];
                        s = xor32_sum(xor16_sum(s));
                        if (fq == 0) ssq[(size_t)row * 20 + slot] = s;
                    }
                }
                if (u.pn == 7 && wc == 1 && fq < 2) {
                    *(f32x4*)(gates + (size_t)row * 16 + 8 * fq) = acc[ai][1][m][0];
                    *(f32x4*)(gates + (size_t)row * 16 + 8 * fq + 4) = acc[ai][1][m][1];
                }
            }
    }
};

struct EpiQ {
    static constexpr bool PERM = true;
    bf16_t* Q; const float* ssq;
    DI void operator()(const AccT& acc, const Unit& u, int wr, int wc, int fr, int fq) const {
        float rstds[2][4];
#pragma unroll
        for (int ai = 0; ai < 2; ++ai) {
            f32x4 sp[4][3];
#pragma unroll
            for (int m = 0; m < 4; ++m) { const f32x4* p = (const f32x4*)(ssq + (size_t)(u.pm * 256 + wr * 64 + fr + ai * 128 + m * 16) * 20); sp[m][0] = p[0]; sp[m][1] = p[1]; sp[m][2] = p[2]; }
#pragma unroll
            for (int m = 0; m < 4; ++m) { const f32x4 s0 = sp[m][0], s1 = sp[m][1], s2 = sp[m][2];
                const float sq = ((s0[0] + s0[1]) + (s0[2] + s0[3])) + ((s1[0] + s1[1]) + (s1[2] + s1[3])) + ((s2[0] + s2[1]) + (s2[2] + s2[3]));
                rstds[ai][m] = rsqrtf(sq * (1.0f / 384.0f) + EPS) * QSCALE; }
            asm volatile("" ::: "memory");
        }
#pragma unroll
        for (int ai = 0; ai < 2; ++ai)
#pragma unroll
            for (int m = 0; m < 4; ++m) {
                const int row = u.pm * 256 + wr * 64 + fr + ai * 128 + m * 16;
                const float rstd = rstds[ai][m];
#pragma unroll
                for (int bj = 0; bj < 2; ++bj) {
                    const f32x4 v0 = acc[ai][bj][m][0] * rstd, v1 = acc[ai][bj][m][1] * rstd;
                    u32x4 w; w.x = pk2(v0[0], v0[1]); w.y = pk2(v0[2], v0[3]); w.z = pk2(v1[0], v1[1]); w.w = pk2(v1[2], v1[3]);
                    *(u32x4*)(Q + (size_t)row * 768 + u.pn * 256 + bj * 128 + wc * 32 + 8 * fq) = w;
                }
                asm volatile("" ::: "memory");
            }
    }
};

struct EpiKV {
    static constexpr bool PERM = true;
    bf16_t* KN; bf16_t* VT; const float* ssq;
    DI void operator()(const AccT& acc, const Unit& u, int wr, int wc, int fr, int fq) const {
        const int b = u.pm / 33, posb = (u.pm % 33) * 256;
        float rstds[2][4];
        {
#pragma unroll
            for (int ai = 0; ai < 2; ++ai) {
                f32x4 sp[4][2];
#pragma unroll
                for (int m = 0; m < 4; ++m) { const f32x4* p = (const f32x4*)(ssq + (size_t)(u.pm * 256 + wr * 64 + fr + ai * 128 + m * 16) * 20 + 12); sp[m][0] = p[0]; sp[m][1] = p[1]; }
#pragma unroll
                for (int m = 0; m < 4; ++m) { const f32x4 s0 = sp[m][0], s1 = sp[m][1];
                    const float sq = ((s0[0] + s0[1]) + (s0[2] + s0[3])) + ((s1[0] + s1[1]) + (s1[2] + s1[3]));
                    rstds[ai][m] = rsqrtf(sq * (1.0f / 256.0f) + EPS); }
                asm volatile("" ::: "memory");
            }
        }
#pragma unroll
        for (int ai = 0; ai < 2; ++ai)
#pragma unroll
            for (int m = 0; m < 4; ++m) {
                const int rl = wr * 64 + fr + ai * 128 + m * 16, row = u.pm * 256 + rl, pos = posb + rl;
                const float rstd = rstds[ai][m];
#pragma unroll
                for (int bj = 0; bj < 2; ++bj) {
                    const int head = 2 * u.pn + bj;
                    float v[8];
#pragma unroll
                    for (int j = 0; j < 4; ++j) { v[j] = acc[ai][bj][m][0][j] * rstd; v[4 + j] = acc[ai][bj][m][1][j] * rstd; }
                    if (wc < 2) {
                        u32x4 w; w.x = pk2(v[0], v[1]); w.y = pk2(v[2], v[3]); w.z = pk2(v[4], v[5]); w.w = pk2(v[6], v[7]);
                        *(u32x4*)(KN + (size_t)row * 512 + head * 64 + wc * 32 + 8 * fq) = w;
                    } else {
                        const int e0 = (wc - 2) * 32 + 8 * fq;
                        bf16_t* dst = VT + ((size_t)(b * 8 + head) * 64 + e0) * TPB + pos;
#pragma unroll
                        for (int j = 0; j < 8; ++j) dst[(size_t)j * TPB] = f2bf(v[j]);
                    }
                }
                asm volatile("" ::: "memory");
            }
    }
};

struct EpiOut {
    static constexpr bool PERM = false;
    xres_t* X; const float* mod; float scale;
    DI void operator()(const AccT& acc, const Unit& u, int wr, int wc, int fr, int fq) const {
        const int b = u.pm / 33, mrow = (u.pm % 33 == 0) ? 8 : b;
        const float* g1 = mod + (size_t)mrow * 6144 + 2048;
        xres_t* xbase = X + (size_t)u.pm * 256 * 1024;
        f32x4 gv[2][2];
#pragma unroll
        for (int bj = 0; bj < 2; ++bj)
#pragma unroll
            for (int n = 0; n < 2; ++n) gv[bj][n] = *(const f32x4*)(g1 + u.pn * 256 + bj * 128 + wc * 32 + 16 * n + 4 * fq) * scale;
#pragma unroll
        for (int ai = 0; ai < 2; ++ai)
#pragma unroll
            for (int mp = 0; mp < 2; ++mp) {
                f32x4 xv[2][2][2];
#pragma unroll
                for (int mm = 0; mm < 2; ++mm) {
                    const size_t ro = (size_t)(wr * 64 + fr + ai * 128 + (2 * mp + mm) * 16) * 1024;
#pragma unroll
                    for (int bj = 0; bj < 2; ++bj)
#pragma unroll
                        for (int n = 0; n < 2; ++n) xv[mm][bj][n] = ldx4(xbase + ro + u.pn * 256 + bj * 128 + wc * 32 + 16 * n + 4 * fq);
                }
#pragma unroll
                for (int mm = 0; mm < 2; ++mm) {
                    const size_t ro = (size_t)(wr * 64 + fr + ai * 128 + (2 * mp + mm) * 16) * 1024;
#pragma unroll
                    for (int bj = 0; bj < 2; ++bj)
#pragma unroll
                        for (int n = 0; n < 2; ++n) stx4(xbase + ro + u.pn * 256 + bj * 128 + wc * 32 + 16 * n + 4 * fq, xv[mm][bj][n] + gv[bj][n] * acc[ai][bj][2 * mp + mm][n]);
                }
            }
    }
};

struct EpiGU {
    static constexpr bool PERM = true;
    bf16_t* H;
    DI void operator()(const AccT& acc, const Unit& u, int wr, int wc, int fr, int fq) const {
#pragma unroll
        for (int ai = 0; ai < 2; ++ai)
#pragma unroll
            for (int m = 0; m < 4; ++m) {
                const int row = u.pm * 256 + wr * 64 + fr + ai * 128 + m * 16;
                float v[8];
#pragma unroll
                for (int j = 0; j < 4; ++j) { v[j] = silu_f(acc[ai][0][m][0][j]) * acc[ai][1][m][0][j]; v[4 + j] = silu_f(acc[ai][0][m][1][j]) * acc[ai][1][m][1][j]; }
                u32x4 w; w.x = pk2(v[0], v[1]); w.y = pk2(v[2], v[3]); w.z = pk2(v[4], v[5]); w.w = pk2(v[6], v[7]);
                *(u32x4*)(H + (size_t)row * 1024 + u.pn * 128 + wc * 32 + 8 * fq) = w;
            }
    }
};

struct EpiDN {
    static constexpr bool PERM = true;
    bf16_t* Y; const float* gatev;
    DI void operator()(const AccT& acc, const Unit& u, int wr, int wc, int fr, int fq) const {
        float gvs[2][4];
#pragma unroll
        for (int ai = 0; ai < 2; ++ai)
#pragma unroll
            for (int m = 0; m < 4; ++m) gvs[ai][m] = gatev[u.pm * 256 + wr * 64 + fr + ai * 128 + m * 16];
#pragma unroll
        for (int ai = 0; ai < 2; ++ai)
#pragma unroll
            for (int m = 0; m < 4; ++m) {
                const int row = u.pm * 256 + wr * 64 + fr + ai * 128 + m * 16;
                const float gv = gvs[ai][m];
#pragma unroll
                for (int bj = 0; bj < 2; ++bj) {
                    const f32x4 v0 = acc[ai][bj][m][0] * gv, v1 = acc[ai][bj][m][1] * gv;
                    u32x4 w; w.x = pk2(v0[0], v0[1]); w.y = pk2(v0[2], v0[3]); w.z = pk2(v1[0], v1[1]); w.w = pk2(v1[2], v1[3]);
                    *(u32x4*)(Y + (size_t)row * 1024 + u.pn * 256 + bj * 128 + wc * 32 + 8 * fq) = w;
                }
            }
    }
};
DI int ropeperm(int p) { return (p & 1) ? 16 + (p >> 1) : (p >> 1); }

DI void phase_prologue(const Args& a, LAS unsigned char* lds) {
    const int tid = tidx();
    LAS float* sc = (LAS float*)lds;
    LAS float* red = (LAS float*)(lds + 9 * 1024 * 4);
    for (int i = tid; i < 9 * 1024; i += NTHR) { const float v = (i < 8192) ? a.c[i] : a.c_ctx[i - 8192]; sc[i] = silu_f(v); }
    __syncthreads();
    float* MOD = (float*)(a.ws + WS_MOD);
    for (int un = bidx(); un < DEPTH * 48; un += gdim()) {
        const int l = un / 48, cb = (un % 48) * 128, col = tid & 127, kq = tid >> 7;
        const float* w = a.ada_w + (size_t)l * 1024 * 6144 + cb + col;
        float acc[9];
#pragma unroll
        for (int r = 0; r < 9; ++r) acc[r] = 0.f;
        for (int k0 = kq * 256; k0 < kq * 256 + 256; k0 += 16) {
            float wv[16];
#pragma unroll
            for (int i = 0; i < 16; ++i) wv[i] = w[(size_t)(k0 + i) * 6144];
#pragma unroll
            for (int i = 0; i < 16; ++i)
#pragma unroll
                for (int r = 0; r < 9; ++r) acc[r] += sc[r * 1024 + k0 + i] * wv[i];
        }
#pragma unroll
        for (int r = 0; r < 9; ++r) red[(kq * 9 + r) * 128 + col] = acc[r];
        __syncthreads();
        for (int i = tid; i < 9 * 128; i += NTHR) {
            const int r = i / 128, cc = i % 128;
            const float s = red[(0 * 9 + r) * 128 + cc] + red[(1 * 9 + r) * 128 + cc] + red[(2 * 9 + r) * 128 + cc] + red[(3 * 9 + r) * 128 + cc];
            MOD[((size_t)l * 9 + r) * 6144 + cb + cc] = s + a.ada_b[(size_t)l * 6144 + cb + cc];
        }
        __syncthreads();
    }
    const int gt = bidx() * NTHR + tid, gn = gdim() * NTHR;
    f32x2* TW = (f32x2*)(a.ws + WS_TW);
    for (int i = gt; i < 8192; i += gn) { float s, c; sincospif((float)i * (1.0f / 4096.0f), &s, &c); TW[i] = (f32x2){c, s}; }
    f32x2* RP = (f32x2*)(a.ws + WS_ROPE);
    for (int i = gt; i < 192 * 8; i += gn) {
        const int id = (i < 1024) ? (i >> 3) : ((i - 1024) >> 3), f = i & 7;
        const float inv = powf(10000.0f, -(float)f / 8.0f), ang = (float)id * inv;
        RP[i] = (f32x2){cosf(ang), sinf(ang)};
    }
    bf16_t* WA = (bf16_t*)(a.ws + WS_WA);
    for (int i = gt; i < 256 * 128; i += gn) {
        const int m = i >> 7, t1 = i & 127, k1 = m & 127, ri = m >> 7;
        float s, c; sincospif((float)((k1 * t1) & 127) * (1.0f / 64.0f), &s, &c);
        WA[i] = f2bf(ri ? -s : c);
    }
    bf16_t* WB = (bf16_t*)(a.ws + WS_WB);
    for (int i = gt; i < 128 * 128; i += gn) {
        const int m = i >> 7, kk = i & 127, k2 = m & 63, ro = m >> 6, t2 = kk >> 1, ri = kk & 1;
        float s, c; sincospif((float)((k2 * t2) & 63) * (1.0f / 32.0f), &s, &c);
        WB[i] = f2bf(ro == 0 ? (ri == 0 ? c : s) : (ri == 0 ? -s : c));
    }
    bf16_t* WC = (bf16_t*)(a.ws + WS_WC);
    for (int i = gt; i < 64 * 128; i += gn) {
        const int l = i >> 7, kk = i & 127, cch = kk & 63, ri = kk >> 6;
        float s, c; sincospif((float)((l * cch) & 63) * (1.0f / 32.0f), &s, &c);
        WC[i] = f2bf(ri ? s : c);
    }
}

constexpr int WPREP_TILES = 32 * 16 + 12 * 6 + 16 * 4 + 16 * 16 + 16 * 32 * 16 + 16 * 16 * 16;
DI void phase_wprep(const Args& a, int l, LAS unsigned char* lds, int t0 = 0, int t1 = WPREP_TILES, int vb = -1, int nvb = 0) {
    if (vb < 0) { vb = bidx(); nvb = gdim(); }
    const int tid = tidx();
    LAS float* tile = (LAS float*)lds;
    constexpr int T_IN = 32 * 16, T_Q = 12 * 6, T_KV = 16 * 4, T_OUT = 16 * 16, T_GU = 16 * 32 * 16, T_DN = 16 * 16 * 16;
    constexpr int O_Q = T_IN, O_KV = O_Q + T_Q, O_OUT = O_KV + T_KV, O_GU = O_OUT + T_OUT, O_DN = O_GU + T_GU, T_ALL = O_DN + T_DN;
    const int grp = tid >> 7, tl = tid & 127;
    LAS float* mytile = tile + grp * (64 * 65);
    static_assert(T_ALL == WPREP_TILES, "tile count");
    __syncthreads();
    for (int base = t0 + vb * 4; base < t1; base += nvb * 4) {
        const int tix = base + grp; const bool valid = tix < t1;
        int kind = 0, e = 0, nt = 0, kt = 0, K = 1024, ldsrc = 1024; bf16_t* dst = nullptr; const float* src = nullptr; const float* kscale = nullptr;
        if (valid) {
            if (tix < O_Q)        { kind = 0; const int t = tix;          nt = t / 16; kt = t % 16; K = 1024; ldsrc = 1968; src = a.w_in + (size_t)l * 1024 * 1968; dst = (bf16_t*)(a.ws + wsw(WS_WIN, l)); }
            else if (tix < O_KV)  { kind = 1; const int t = tix - O_Q;    nt = t / 6;  kt = t % 6;  K = 384;  ldsrc = 768;  src = a.a_wq_up + (size_t)l * 384 * 768; dst = (bf16_t*)(a.ws + wsw(WS_WQ, l)); kscale = a.a_qnorm_g + l * 384; }
            else if (tix < O_OUT) { kind = 2; const int t = tix - O_KV;   nt = t / 4;  kt = t % 4;  K = 256;  ldsrc = 1024; src = a.a_wkv_up + (size_t)l * 256 * 1024; dst = (bf16_t*)(a.ws + wsw(WS_WKV, l)); kscale = a.a_kvnorm_g + l * 256; }
            else if (tix < O_GU)  { kind = 3; const int t = tix - O_OUT;  nt = t / 16; kt = t % 16; K = 1024; ldsrc = 1024; src = a.w_out + (size_t)l * 1024 * 1024; dst = (bf16_t*)(a.ws + wsw(WS_WOUT, l)); }
            else if (tix < O_DN)  { kind = 4; const int t = tix - O_GU;   e = t / 512; nt = (t % 512) / 16; kt = t % 16; K = 1024; ldsrc = 1024; src = nullptr; dst = (bf16_t*)(a.ws + wsw(WS_WGU, l)) + (size_t)e * 2048 * 1024; }
            else                  { kind = 5; const int t = tix - O_DN;   e = t / 256; nt = (t % 256) / 16; kt = t % 16; K = 1024; ldsrc = 1024; src = a.e_w_down + ((size_t)l * 16 + e) * 1024 * 1024; dst = (bf16_t*)(a.ws + wsw(WS_WDN, l)) + (size_t)e * 1024 * 1024; }
            const int nl = tl & 63, n = nt * 64 + nl;
            int col = n; const float* s2 = src;
            if (kind == 0) { if (n < 1280) col = n; else if (n < 1920) col = n + 16; else if (n < 1952) col = 1936 + ropeperm(n - 1920); else if (n < 1968) col = 1280 + (n - 1952); else col = -1; }
            else if (kind == 1) { const int h = n / 96, j = n % 96; col = (j < 64) ? n : h * 96 + 64 + ropeperm(j - 64); }
            else if (kind == 4) { const int pn = n >> 8, bj = (n >> 7) & 1, j = n & 127; col = pn * 128 + j; s2 = (bj ? a.e_w_up : a.e_w_gate) + ((size_t)l * 16 + e) * 1024 * 1024; }
            float v[32];
#pragma unroll
            for (int i = 0; i < 32; ++i) {
                const int kl = (tl >> 6) + 2 * i, k = kt * 64 + kl;
                v[i] = (col >= 0) ? s2[(size_t)k * ldsrc + col] : 0.f;
            }
            if (kscale) {
#pragma unroll
                for (int i = 0; i < 32; ++i) v[i] *= kscale[kt * 64 + (tl >> 6) + 2 * i];
            }
#pragma unroll
            for (int i = 0; i < 32; ++i) mytile[nl * 65 + (tl >> 6) + 2 * i] = v[i];
        }
        __syncthreads();
        if (valid) {
#pragma unroll
            for (int q = 0; q < 4; ++q) {
                const int ch = tl + 128 * q, nl2 = ch >> 3, kc = (ch & 7) * 8;
                const LAS float* tp = mytile + nl2 * 65 + kc;
                u32x4 w; w.x = pk2(tp[0], tp[1]); w.y = pk2(tp[2], tp[3]); w.z = pk2(tp[4], tp[5]); w.w = pk2(tp[6], tp[7]);
                *(u32x4*)(dst + (size_t)(nt * 64 + nl2) * K + kt * 64 + kc) = w;
            }
        }
        __syncthreads();
    }
}

template <bool FIRST, bool FINAL>
DI void phase_norm1(const Args& a, int l, LAS unsigned char* lds, float cscale = 1.0f) {
    constexpr int NPRE = 4;
    const int tid = tidx(), lane = tid & 63, wid = tid >> 6;
    xres_t* X = (xres_t*)(a.ws + WS_X); bf16_t* XN = (bf16_t*)(a.ws + WS_XN);
    const float* MOD = (const float*)(a.ws + WS_MOD);
    const int* INV = (const int*)(a.ws + WS_R4 + R4_INV); const bf16_t* YE = (const bf16_t*)(a.ws + WS_R1);
    if (!FINAL && bidx() == 0 && tid < 72) ((unsigned*)(a.ws + WS_R4 + R4_KMAX))[tid] = 0u;
    constexpr int NR = FINAL ? NB * SEQ : NROW;
    const int rpb = (NR + gdim() - 1) / gdim(), j_lo = bidx() * rpb, j_hi = (j_lo + rpb < NR) ? j_lo + rpb : NR;
    const int b0 = FINAL ? (j_lo >> 13) : (j_lo / TPB);
    LAS float* g2l = (LAS float*)lds;
    LAS float* gsl = g2l + 3 * 1024;
    LAS float* shl = gsl + 3 * 1024;
    __syncthreads();
    for (int i = tid; i < 3 * 1024; i += NTHR) {
        const int st = i >> 10, c = i & 1023; int mrow = (st == 2) ? 8 : b0 + st; if (st < 2 && mrow > 7) mrow = 7;
        if (!FIRST) g2l[i] = MOD[((size_t)(l - 1) * 9 + mrow) * 6144 + 5 * 1024 + c] * cscale;
        if (FINAL) gsl[i] = a.final_g[c];
        else { const float* sh = MOD + ((size_t)l * 9 + mrow) * 6144; gsl[i] = a.norm1_g[(size_t)l * 1024 + c] * (1.0f + sh[1024 + c]); shl[i] = sh[c]; }
    }
    __syncthreads();
#define N1_ROWOF(j) (FINAL ? ((j) >> 13) * TPB + CTXL + ((j) & 8191) : (j))
    int j = j_lo + wid;
    if (FIRST) {
        f32x4 nx[4];
        if (j < j_hi) {
            const int b = j / TPB, pos = j % TPB;
            const float* src = (pos < CTXL) ? a.ctx + ((size_t)b * CTXL + pos) * 1024 : a.x + ((size_t)b * SEQ + (pos - CTXL)) * 1024;
#pragma unroll
            for (int i = 0; i < 4; ++i) nx[i] = *(const f32x4*)(src + 4 * lane + 256 * i);
        }
        for (; j < j_hi; j += NTHR / 64) {
            f32x4 v[4];
#pragma unroll
            for (int i = 0; i < 4; ++i) v[i] = nx[i];
            const int jn = j + NTHR / 64;
            if (jn < j_hi) {
                const int b = jn / TPB, pos = jn % TPB;
                const float* src = (pos < CTXL) ? a.ctx + ((size_t)b * CTXL + pos) * 1024 : a.x + ((size_t)b * SEQ + (pos - CTXL)) * 1024;
#pragma unroll
                for (int i = 0; i < 4; ++i) nx[i] = *(const f32x4*)(src + 4 * lane + 256 * i);
            }
            asm volatile("" ::: "memory");
            const int row = j, b = row / TPB, pos = row % TPB; const int st = (pos < CTXL) ? 2 : b - b0;
            float ss = 0.f;
#pragma unroll
            for (int i = 0; i < 4; ++i) ss += v[i][0] * v[i][0] + v[i][1] * v[i][1] + v[i][2] * v[i][2] + v[i][3] * v[i][3];
            ss = wave_sum(ss);
            const float rstd = rsqrtf(ss * (1.0f / 1024.0f) + EPS);
#pragma unroll
            for (int i = 0; i < 4; ++i) {
                const int c = 4 * lane + 256 * i;
                stx4(X + (size_t)row * 1024 + c, v[i]);
                const f32x4 y = v[i] * rstd * *(const LAS f32x4*)(gsl + st * 1024 + c) + *(const LAS f32x4*)(shl + st * 1024 + c);
                u32x2 w; w.x = pk2(y[0], y[1]); w.y = pk2(y[2], y[3]);
                *(u32x2*)(XN + (size_t)row * 1024 + c) = w;
            }
        }
    } else {
#ifndef X_F32
        typedef u32x2 xraw_t;
#define N1_XEXP(w) bf4(w)
#else
        typedef f32x4 xraw_t;
#define N1_XEXP(w) (w)
#endif
#define N1_LOADROW(ROW, INVV, XR, YR, SR, MREST) do { \
            _Pragma("unroll") for (int q = 0; q < NPRE; ++q) { SR[q] = -1; _Pragma("unroll") for (int i = 0; i < 4; ++i) YR[q][i] = (u32x2){0u, 0u}; } \
            MREST = 0ull; \
            if ((ROW) >= 0) { \
                _Pragma("unroll") for (int i = 0; i < 4; ++i) XR[i] = *(const xraw_t*)(X + (size_t)(ROW) * 1024 + 4 * lane + 256 * i); \
                unsigned long long mk_ = __ballot((INVV) >= 0) & 0xFFFFull; \
                _Pragma("unroll") for (int q = 0; q < NPRE; ++q) { \
                    if (mk_) { const int e_ = __builtin_ctzll(mk_); mk_ &= mk_ - 1; SR[q] = __builtin_amdgcn_readlane((INVV), e_); \
                        const bf16_t* yp_ = YE + (size_t)SR[q] * 1024; \
                        _Pragma("unroll") for (int i = 0; i < 4; ++i) YR[q][i] = *(const u32x2*)(yp_ + 4 * lane + 256 * i); } } \
                MREST = mk_; } } while (0)
        int rowc = (j < j_hi) ? N1_ROWOF(j) : -1;
        int rown = (j + 8 < j_hi) ? N1_ROWOF(j + 8) : -1;
        int invc = (rowc >= 0) ? INV[(size_t)rowc * 16 + (lane & 15)] : -1;
        int invn = (rown >= 0) ? INV[(size_t)rown * 16 + (lane & 15)] : -1;
        xraw_t xc[4]; u32x2 yc[NPRE][4]; int sc[NPRE]; unsigned long long mrc;
#pragma unroll
        for (int i = 0; i < 4; ++i) xc[i] = (xraw_t){};
        N1_LOADROW(rowc, invc, xc, yc, sc, mrc);
        for (; j < j_hi; j += NTHR / 64) {
            xraw_t xn[4]; u32x2 yn[NPRE][4]; int sn[NPRE]; unsigned long long mrn;
#pragma unroll
            for (int i = 0; i < 4; ++i) xn[i] = (xraw_t){};
            N1_LOADROW(rown, invn, xn, yn, sn, mrn);
            const int row2 = (j + 16 < j_hi) ? N1_ROWOF(j + 16) : -1;
            const int inv2 = (row2 >= 0) ? INV[(size_t)row2 * 16 + (lane & 15)] : -1;
            asm volatile("" ::: "memory");
            const int row = rowc, b = row / TPB, pos = row % TPB; const int st = (pos < CTXL) ? 2 : b - b0;
            f32x4 v[4], acc[4];
#pragma unroll
            for (int i = 0; i < 4; ++i) { v[i] = N1_XEXP(xc[i]); acc[i] = (f32x4){0.f, 0.f, 0.f, 0.f}; }
#pragma unroll
            for (int q = 0; q < NPRE; ++q)
                if (sc[q] >= 0) {
#pragma unroll
                    for (int i = 0; i < 4; ++i) acc[i] += bf4(yc[q][i]);
                }
            while (mrc) {
                const int e0 = __builtin_ctzll(mrc); mrc &= mrc - 1;
                const int s0 = __builtin_amdgcn_readlane(invc, e0);
                const bf16_t* y0 = YE + (size_t)s0 * 1024;
                u32x2 w0[4];
#pragma unroll
                for (int i = 0; i < 4; ++i) w0[i] = *(const u32x2*)(y0 + 4 * lane + 256 * i);
#pragma unroll
                for (int i = 0; i < 4; ++i) acc[i] += bf4(w0[i]);
            }
#pragma unroll
            for (int i = 0; i < 4; ++i) v[i] += *(const LAS f32x4*)(g2l + st * 1024 + 4 * lane + 256 * i) * acc[i];
            float ss = 0.f;
#pragma unroll
            for (int i = 0; i < 4; ++i) ss += v[i][0] * v[i][0] + v[i][1] * v[i][1] + v[i][2] * v[i][2] + v[i][3] * v[i][3];
            ss = wave_sum(ss);
            const float rstd = rsqrtf(ss * (1.0f / 1024.0f) + EPS);
            if (FINAL) {
                float* o = a.out + ((size_t)b * SEQ + (pos - CTXL)) * 1024;
#pragma unroll
                for (int i = 0; i < 4; ++i) *(f32x4*)(o + 4 * lane + 256 * i) = v[i] * rstd * *(const LAS f32x4*)(gsl + 4 * lane + 256 * i);
            } else {
#pragma unroll
                for (int i = 0; i < 4; ++i) {
                    const int c = 4 * lane + 256 * i;
                    stx4(X + (size_t)row * 1024 + c, v[i]);
                    const f32x4 y = v[i] * rstd * *(const LAS f32x4*)(gsl + st * 1024 + c) + *(const LAS f32x4*)(shl + st * 1024 + c);
                    u32x2 w; w.x = pk2(y[0], y[1]); w.y = pk2(y[2], y[3]);
                    *(u32x2*)(XN + (size_t)row * 1024 + c) = w;
                }
            }
#pragma unroll
            for (int i = 0; i < 4; ++i) xc[i] = xn[i];
#pragma unroll
            for (int q = 0; q < NPRE; ++q) { sc[q] = sn[q];
#pragma unroll
                for (int i = 0; i < 4; ++i) yc[q][i] = yn[q][i]; }
            mrc = mrn; rowc = rown; invc = invn; rown = row2; invn = inv2;
        }
#undef N1_LOADROW
#undef N1_XEXP
    }
#undef N1_ROWOF
    __syncthreads();
}

DI void phase_norm2_router(const Args& a, int l, LAS unsigned char* lds) {
    const int tid = tidx(), lane = tid & 63, wid = tid >> 6;
    LAS float* rw = (LAS float*)lds;
    LAS float* gsl = rw + 1024 * 20;
    LAS float* shl = gsl + 3 * 1024;
    const int rpb = (NROW + gdim() - 1) / gdim(), row_lo = bidx() * rpb, row_hi = (row_lo + rpb < NROW) ? row_lo + rpb : NROW;
    const int b0 = row_lo / TPB;
    const float* MOD = (const float*)(a.ws + WS_MOD);
    {
        const float* rsrc = a.router_w + (size_t)l * 1024 * 16;
        for (int i = tid; i < 1024 * 16; i += NTHR) { const int c = i >> 4; rw[((c & 3) * 256 + (c >> 2)) * 20 + (i & 15)] = rsrc[i]; }
        const float* g = a.norm2_g + (size_t)l * 1024;
        for (int i = tid; i < 3 * 1024; i += NTHR) {
            const int st = i >> 10, c = i & 1023; int mrow = (st == 2) ? 8 : b0 + st; if (mrow > 8) mrow = 8; if (st < 2 && mrow > 7) mrow = 7;
            const float* sh = MOD + ((size_t)l * 9 + mrow) * 6144 + 3 * 1024;
            gsl[i] = g[c] * (1.0f + sh[1024 + c]); shl[i] = sh[c];
        }
    }
    __syncthreads();
    const xres_t* X = (const xres_t*)(a.ws + WS_X); bf16_t* HX = (bf16_t*)(a.ws + WS_XN);
    float* AFF = (float*)(a.ws + WS_R4 + R4_AFF); int* INV = (int*)(a.ws + WS_R4 + R4_INV);
    int row = row_lo + wid;
#ifndef X_F32
    typedef u32x2 xr_t;
#define N2_EXP(w) bf4(w)
#else
    typedef f32x4 xr_t;
#define N2_EXP(w) (w)
#endif
    xr_t nxa[2][4], nxb[2][4];
#pragma unroll
    for (int p = 0; p < 2; ++p)
#pragma unroll
        for (int i = 0; i < 4; ++i) { nxa[p][i] = (xr_t){}; nxb[p][i] = (xr_t){}; }
#define N2_LOAD(DST, R0) do { _Pragma("unroll") for (int p_ = 0; p_ < 2; ++p_) { const int r_ = (R0) + 8 * p_; if (r_ < row_hi) { \
        _Pragma("unroll") for (int i_ = 0; i_ < 4; ++i_) DST[p_][i_] = *(const xr_t*)(X + (size_t)r_ * 1024 + 4 * lane + 256 * i_); } } } while (0)
    N2_LOAD(nxa, row); N2_LOAD(nxb, row + 16);
    for (; row < row_hi; row += 16) {
        f32x4 v[2][4];
#pragma unroll
        for (int p = 0; p < 2; ++p)
#pragma unroll
            for (int i = 0; i < 4; ++i) { v[p][i] = N2_EXP(nxa[p][i]); nxa[p][i] = nxb[p][i]; }
        N2_LOAD(nxb, row + 32);
        const bool val1 = row + 8 < row_hi;
        const int rw1 = val1 ? row + 8 : row;
        int st[2]; float rstd[2];
#pragma unroll
        for (int p = 0; p < 2; ++p) {
            const int rr = p ? rw1 : row, b = rr / TPB, pos = rr % TPB; st[p] = (pos < CTXL) ? 2 : (b - b0);
            float ss = 0.f;
#pragma unroll
            for (int i = 0; i < 4; ++i) ss += v[p][i][0] * v[p][i][0] + v[p][i][1] * v[p][i][1] + v[p][i][2] * v[p][i][2] + v[p][i][3] * v[p][i][3];
            ss = wave_sum(ss);
            rstd[p] = rsqrtf(ss * (1.0f / 1024.0f) + EPS);
        }
        f32x2 lgp[2][8];
#pragma unroll
        for (int p = 0; p < 2; ++p)
#pragma unroll
            for (int e = 0; e < 8; ++e) lgp[p][e] = (f32x2){0.f, 0.f};
#pragma unroll
        for (int i = 0; i < 4; ++i) {
            const int c = 4 * lane + 256 * i;
            f32x2 hp[2][2];
#pragma unroll
            for (int p = 0; p < 2; ++p) {
                const f32x4 gs4 = *(const LAS f32x4*)(gsl + st[p] * 1024 + c), sh4 = *(const LAS f32x4*)(shl + st[p] * 1024 + c);
                const f32x4 h4 = v[p][i] * rstd[p] * gs4 + sh4;
                u32x2 w; w.x = pk2(h4[0], h4[1]); w.y = pk2(h4[2], h4[3]);
                if (p == 0 || val1) *(u32x2*)(HX + (size_t)(p ? rw1 : row) * 1024 + c) = w;
                hp[p][0] = (f32x2){h4[0], h4[1]}; hp[p][1] = (f32x2){h4[2], h4[3]};
            }
#pragma unroll
            for (int j = 0; j < 4; ++j) {
                const LAS f32x4* wp = (const LAS f32x4*)(rw + (j * 256 + lane + 64 * i) * 20);
#pragma unroll
                for (int q = 0; q < 4; ++q) {
                    const f32x4 w4 = wp[q];
                    const f32x2 wa = {w4[0], w4[1]}, wb = {w4[2], w4[3]};
#pragma unroll
                    for (int p = 0; p < 2; ++p) {
                        if (j & 1) {
                            asm("v_pk_fma_f32 %0, %1, %2, %0 op_sel:[1,0,0] op_sel_hi:[1,1,1]" : "+v"(lgp[p][2 * q]) : "v"(hp[p][j >> 1]), "v"(wa));
                            asm("v_pk_fma_f32 %0, %1, %2, %0 op_sel:[1,0,0] op_sel_hi:[1,1,1]" : "+v"(lgp[p][2 * q + 1]) : "v"(hp[p][j >> 1]), "v"(wb));
                        } else {
                            asm("v_pk_fma_f32 %0, %1, %2, %0 op_sel_hi:[0,1,1]" : "+v"(lgp[p][2 * q]) : "v"(hp[p][j >> 1]), "v"(wa));
                            asm("v_pk_fma_f32 %0, %1, %2, %0 op_sel_hi:[0,1,1]" : "+v"(lgp[p][2 * q + 1]) : "v"(hp[p][j >> 1]), "v"(wb));
                        }
                    }
                }
            }
            asm volatile("" ::: "memory");
        }
#pragma unroll
        for (int p = 0; p < 2; ++p) {
            float lg[16];
#pragma unroll
            for (int e = 0; e < 8; ++e) { lg[2 * e] = lgp[p][e][0]; lg[2 * e + 1] = lgp[p][e][1]; }
#pragma unroll
            for (int i = 0; i < 8; ++i) lg[i] = tsum32(lg[i], lg[i + 8]);
#pragma unroll
            for (int i = 0; i < 4; ++i) lg[i] = tsum16(lg[i], lg[i + 4]);
#pragma unroll
            for (int i = 0; i < 2; ++i) { const bool up = lane & 8; const float send = up ? lg[i] : lg[i + 2], keep = up ? lg[i + 2] : lg[i]; lg[i] = keep + dppf<0x128>(send); }
            { const bool up = lane & 4; const float send = up ? lg[0] : lg[1], keep = up ? lg[1] : lg[0]; lg[0] = keep + dppf<0x1B>(dppf<0x141>(send)); }
            float t = lg[0]; t += dppf<0xB1>(t); t += dppf<0x4E>(t);
            const int e = lane & 15, srcl = ((e >> 3) & 1) * 32 + ((e >> 2) & 1) * 16 + ((e >> 1) & 1) * 8 + (e & 1) * 4;
            const float le = __shfl(t, srcl);
            const float mx = row_max16(le);
            const float ex = expf(le - mx);
            const float sm = row_sum16(ex);
            if (lane < 16 && (p == 0 || val1)) { const int rr = p ? rw1 : row; AFF[(size_t)rr * 16 + lane] = ex / sm; INV[(size_t)rr * 16 + lane] = -1; }
        }
    }
#undef N2_LOAD
#undef N2_EXP
    __syncthreads();
}

DI void phase_topk(const Args& a, LAS unsigned char* lds) {
    const int tid = tidx(), lane = tid & 63, wid = tid >> 6;
    LAS unsigned* hist = (LAS unsigned*)lds;
    LAS unsigned* sh = hist + 256;
    const float* AFF = (const float*)(a.ws + WS_R4 + R4_AFF); int* INV = (int*)(a.ws + WS_R4 + R4_INV);
    int* SEL = (int*)(a.ws + WS_R4 + R4_SEL); float* GATEV = (float*)(a.ws + WS_R4 + R4_GATEV);
    for (int un = bidx(); un < 2 * NB * NEXP; un += gdim()) {
        const bool isctx = un >= NB * NEXP; const int ue = un % (NB * NEXP), b = ue / NEXP, e = ue % NEXP;
        const int n = isctx ? CTXL : SEQ, cap = isctx ? CAPC : CAPX, rowb = b * TPB + (isctx ? 0 : CTXL);
        const int slotb = e * EROWS + (isctx ? NB * CAPX + b * CAPC : b * CAPX);
        unsigned key[16];
#pragma unroll
        for (int i = 0; i < 16; ++i) { const int t = tid * 16 + i; key[i] = (t < n) ? __float_as_uint(AFF[(size_t)(rowb + t) * 16 + e]) : 0u; }
        unsigned prefix = 0u, kth = (unsigned)cap;
        for (int shift = 24; shift >= 0; shift -= 8) {
            if (tid < 256) hist[tid] = 0u;
            __syncthreads();
            const unsigned himask = (shift == 24) ? 0u : (0xFFFFFFFFu << (shift + 8));
#pragma unroll
            for (int i = 0; i < 16; ++i) { const int t = tid * 16 + i; if (t < n && (key[i] & himask) == prefix) __hip_atomic_fetch_add(&hist[(key[i] >> shift) & 255u], 1u, __ATOMIC_RELAXED, __HIP_MEMORY_SCOPE_WORKGROUP); }
            __syncthreads();
            if (tid < 64) {
                const unsigned c0 = hist[255 - 4 * lane], c1 = hist[254 - 4 * lane], c2 = hist[253 - 4 * lane], c3 = hist[252 - 4 * lane];
                const unsigned tot = c0 + c1 + c2 + c3;
                unsigned inc = tot;
#pragma unroll
                for (int o = 1; o < 64; o <<= 1) { const unsigned v = __shfl_up(inc, o); if (lane >= o) inc += v; }
                const unsigned long long bal = __ballot(inc >= kth);
                const int fl = __builtin_ctzll(bal);
                if (lane == fl) {
                    unsigned cum = inc - tot; int bin;
                    if (cum + c0 >= kth) bin = 255 - 4 * lane;
                    else { cum += c0; if (cum + c1 >= kth) bin = 254 - 4 * lane; else { cum += c1; if (cum + c2 >= kth) bin = 253 - 4 * lane; else { cum += c2; bin = 252 - 4 * lane; } } }
                    sh[0] = prefix | ((unsigned)bin << shift); sh[1] = kth - cum;
                }
            }
            __syncthreads();
            prefix = sh[0]; kth = sh[1];
            __syncthreads();
        }
        unsigned cnt = 0u;
#pragma unroll
        for (int i = 0; i < 16; ++i) { const int t = tid * 16 + i; if (t < n) { if (key[i] > prefix) cnt += 1u; else if (key[i] == prefix) cnt += 0x10000u; } }
        unsigned inc = cnt;
#pragma unroll
        for (int o = 1; o < 64; o <<= 1) { const unsigned v = __shfl_up(inc, o); if (lane >= o) inc += v; }
        if (lane == 63) sh[8 + wid] = inc;
        __syncthreads();
        unsigned base = 0u;
        for (int w = 0; w < wid; ++w) base += sh[8 + w];
        unsigned run = base + inc - cnt;
#pragma unroll
        for (int i = 0; i < 16; ++i) {
            const int t = tid * 16 + i;
            if (t < n) {
                const unsigned gtb = run & 0xFFFFu, eqb = run >> 16;
                bool take = false;
                if (key[i] > prefix) { take = true; run += 1u; }
                else if (key[i] == prefix) { take = eqb < kth; run += 0x10000u; }
                if (take) {
                    const int slot = slotb + (int)(gtb + (eqb < kth ? eqb : kth));
                    SEL[slot] = rowb + t; GATEV[slot] = __uint_as_float(key[i]); INV[(size_t)(rowb + t) * 16 + e] = slot;
                }
            }
        }
        __syncthreads();
    }
}
DI void phase_attention(const Args& a, int l, LAS unsigned char* lds) {
    const int tid = tidx(), lane = tid & 63, wid = tid >> 6, r = lane & 31, hh = lane >> 5;
    const bf16_t* Q = (const bf16_t*)(a.ws + WS_R2 + R2_Q); const bf16_t* KN = (const bf16_t*)(a.ws + WS_R2 + R2_KN);
    const bf16_t* VT = (const bf16_t*)(a.ws + WS_R2 + R2_VT); const bf16_t* KR = (const bf16_t*)(a.ws + WS_R2 + R2_KR);
    bf16_t* MIX = (bf16_t*)(a.ws + WS_XN);
    constexpr int KSTR = 208, VSTR = 144, KBUF = 64 * KSTR, VBUF = 64 * VSTR;
    LAS unsigned char* Kl = lds; LAS unsigned char* Vl = lds + 2 * KBUF;
    const int nun = NB * 8 * 32 + ((l < DEPTH - 1) ? NB * 8 : 0);
    const unsigned* KMAX = (const unsigned*)(a.ws + WS_R4 + R4_KMAX);
    for (int un = bidx(); un < nun; un += gdim()) {
        int b, h, qrow0, nt;
        int tstart = 0;
        if (un < NB * 8 * 32) { b = un >> 8; h = un & 7; qrow0 = b * TPB + CTXL + ((un >> 3) & 31) * 256; nt = TPB / 64; tstart = ((un >> 3) & 31) * 4; }
        else { const int u2 = un - NB * 8 * 32; b = u2 >> 3; h = u2 & 7; qrow0 = b * TPB; nt = CTXL / 64; }
        const int key0 = b * TPB;
        const int kk0 = tid / 12, kp0 = tid % 12, kk1 = (512 + (tid >> 1)) / 12, kp1 = (512 + (tid >> 1)) % 12;
        const bf16_t* kptr0 = (kp0 < 8) ? KN + (size_t)(key0 + kk0) * 512 + h * 64 + kp0 * 8 : KR + (size_t)(key0 + kk0) * 32 + (kp0 - 8) * 8;
        const bf16_t* kptr1 = (kp1 < 8) ? KN + (size_t)(key0 + kk1) * 512 + h * 64 + kp1 * 8 : KR + (size_t)(key0 + kk1) * 32 + (kp1 - 8) * 8;
        const bf16_t* kptr1h = kptr1 + 4 * (tid & 1);
        const unsigned kst0 = (kp0 < 8) ? 64 * 512 * 2 : 64 * 32 * 2, kst1 = (kp1 < 8) ? 64 * 512 * 2 : 64 * 32 * 2;
        const int ve = tid >> 3, vp = tid & 7;
        const bf16_t* vptr = VT + ((size_t)(b * 8 + h) * 64 + ve) * TPB + vp * 8;
        const unsigned char* wsb = a.ws;
        const unsigned ko0 = (unsigned)((const unsigned char*)kptr0 - wsb), ko1 = (unsigned)((const unsigned char*)kptr1h - wsb), vo = (unsigned)((const unsigned char*)vptr - wsb);
        const int kw0 = kk0 * KSTR + kp0 * 16, kw1 = kk1 * KSTR + kp1 * 16 + 8 * (tid & 1);
        const int vwl = ve * VSTR + (16 * (vp >> 1) + ((vp & 1) ? 4 : 0)) * 2, vwh = ve * VSTR + (16 * (vp >> 1) + ((vp & 1) ? 12 : 8)) * 2;
        bf16x8 qf[6];
        { const bf16_t* qp = Q + (size_t)(qrow0 + wid * 32 + r) * 768 + h * 96 + 8 * hh;
#pragma unroll
          for (int ks = 0; ks < 6; ++ks) qf[ks] = *(const bf16x8*)(qp + 16 * ks); }
        if (un < NB * 8 * 32) {
            const f32x2* RP = (const f32x2*)(a.ws + WS_ROPE);
            const int tp = qrow0 + wid * 32 + r - b * TPB - CTXL, rr = tp >> 6, cc = tp & 63;
            const f32x4* tr = (const f32x4*)(RP + rr * 8 + 4 * hh); const f32x4* tc = (const f32x4*)(RP + 1024 + cc * 8 + 4 * hh);
            const f32x4 r0 = tr[0], r1 = tr[1], c0 = tc[0], c1 = tc[1];
            const float csr[8] = {r0[0], r0[1], r0[2], r0[3], r1[0], r1[1], r1[2], r1[3]}, csc[8] = {c0[0], c0[1], c0[2], c0[3], c1[0], c1[1], c1[2], c1[3]};
            u32x4 w4, w5;
#pragma unroll
            for (int q = 0; q < 4; ++q) {
                const float a1 = bf2f((bf16_t)qf[4][2 * q]), a2 = bf2f((bf16_t)qf[4][2 * q + 1]);
                w4[q] = pk2(a1 * csr[2 * q] - a2 * csr[2 * q + 1], a1 * csr[2 * q + 1] + a2 * csr[2 * q]);
                const float b1 = bf2f((bf16_t)qf[5][2 * q]), b2 = bf2f((bf16_t)qf[5][2 * q + 1]);
                w5[q] = pk2(b1 * csc[2 * q] - b2 * csc[2 * q + 1], b1 * csc[2 * q + 1] + b2 * csc[2 * q]);
            }
            qf[4] = __builtin_bit_cast(bf16x8, w4); qf[5] = __builtin_bit_cast(bf16x8, w5);
        }
        bool fast;
        {
            float qn2 = 0.f;
#pragma unroll
            for (int ks = 0; ks < 6; ++ks)
#pragma unroll
                for (int jx = 0; jx < 8; ++jx) { const float qv = bf2f((bf16_t)qf[ks][jx]); qn2 += qv * qv; }
            qn2 = xor32_sum(qn2);
            const float kmax2 = __uint_as_float(KMAX[b * 8 + h]) + __uint_as_float(KMAX[64 + b]);
#ifdef PROBE_SAFE_ATTN
            fast = __all(qn2 * kmax2 < 0.0f) != 0;
#else
            fast = __all(qn2 * kmax2 < 90.0f * 90.0f) != 0;
#endif
        }
        f32x16 o0, o1, sA0, sA1, sB0, sB1;
#pragma unroll
        for (int i = 0; i < 16; ++i) { o0[i] = 0.f; o1[i] = 0.f; }
        float m_run = -1e30f, l_run = 0.f;
        __syncthreads();
        {
            const int t0 = tstart, t1 = (tstart + 1 >= nt) ? tstart + 1 - nt : tstart + 1;
            const u32x4 k0 = *(const u32x4*)(wsb + (ko0 + (unsigned)t0 * kst0)); const u32x2 k1 = *(const u32x2*)(wsb + (ko1 + (unsigned)t0 * kst1));
            const u32x4 v0 = *(const u32x4*)(wsb + (vo + (unsigned)t0 * 128u));
            const u32x4 k2 = *(const u32x4*)(wsb + (ko0 + (unsigned)t1 * kst0)); const u32x2 k3 = *(const u32x2*)(wsb + (ko1 + (unsigned)t1 * kst1));
            *(LAS u32x4*)(Kl + kw0) = k0; *(LAS u32x2*)(Kl + kw1) = k1;
            *(LAS u32x4*)(Kl + KBUF + kw0) = k2; *(LAS u32x2*)(Kl + KBUF + kw1) = k3;
            *(LAS u32x2*)(Vl + vwl) = (u32x2){v0.x, v0.y}; *(LAS u32x2*)(Vl + vwh) = (u32x2){v0.z, v0.w};
        }
        __syncthreads();
#define ATT_VF_QK(SN0, SN1) do { \
            _Pragma("unroll") for (int i = 0; i < 16; ++i) { SN0[i] = 0.f; SN1[i] = 0.f; } \
            _Pragma("unroll") for (int ks = 0; ks < 6; ++ks) { \
                const bf16x8 ka = *(const LAS bf16x8*)(kb_ + r * KSTR + ks * 32 + hh * 16); \
                const bf16x8 kb2 = *(const LAS bf16x8*)(kb_ + (32 + r) * KSTR + ks * 32 + hh * 16); \
                SN0 = MFMA32(ka, qf[ks], SN0); SN1 = MFMA32(kb2, qf[ks], SN1); \
                if (ks == 2) asm volatile("" ::: "memory");        \
            } } while (0)
#define ATT_STEP(KT, SC0, SC1, SN0, SN1, FAST, LK0, LK1, LV, WK0, WK1, WV) do { \
            const int kt_ = (KT); const int bufc = kt_ & 1; \
            int tk = kt_ + 2 + tstart, tv = kt_ + 1 + tstart; tk = (tk >= nt) ? tk - nt : tk; tk = (tk >= nt) ? tk - nt : tk; tv = (tv >= nt) ? tv - nt : tv; tv = (tv >= nt) ? tv - nt : tv; \
            LK0 = *(const u32x4*)(wsb + (ko0 + (unsigned)tk * kst0)); LK1 = *(const u32x2*)(wsb + (ko1 + (unsigned)tk * kst1)); \
            LV = *(const u32x4*)(wsb + (vo + (unsigned)tv * 128u)); \
            const LAS unsigned char* kb_ = Kl + (bufc ^ 1) * KBUF; \
            const LAS unsigned char* vb_ = Vl + bufc * VBUF; \
            float ps = 0.f; \
            bf16x8 vf[8]; \
            if (FAST) { \
                __builtin_amdgcn_s_setprio(2); \
                ATT_VF_QK(SN0, SN1); \
                _Pragma("unroll") for (int q = 0; q < 2; ++q) { vf[2 * q] = *(const LAS bf16x8*)(vb_ + r * VSTR + (16 * q + 8 * hh) * 2); vf[2 * q + 1] = *(const LAS bf16x8*)(vb_ + (32 + r) * VSTR + (16 * q + 8 * hh) * 2); }        \
                _Pragma("unroll") for (int i = 0; i < 16; ++i) { SC0[i] = __builtin_amdgcn_exp2f(SC0[i]); ps += SC0[i]; if (i < 8) { SC1[i] = __builtin_amdgcn_exp2f(SC1[i]); ps += SC1[i]; } }        \
                asm volatile("" : "+v"(ps)); \
            } else { \
                float mx = max3f(SC0[0], SC1[0], SC0[1]); mx = max3f(mx, SC1[1], SC0[2]); \
                _Pragma("unroll") for (int i = 2; i < 15; ++i) mx = max3f(mx, SC1[i], SC0[i + 1]); \
                mx = fmaxf(mx, SC1[15]); \
                mx = xor32_max(mx); \
                if (__any(mx > m_run + 8.0f)) {        \
                    const float m_new = fmaxf(m_run, mx), alpha = __builtin_amdgcn_exp2f(m_run - m_new); \
                    m_run = m_new; l_run *= alpha; \
                    _Pragma("unroll") for (int i = 0; i < 16; ++i) { o0[i] *= alpha; o1[i] *= alpha; } } \
                ATT_VF_QK(SN0, SN1); \
                _Pragma("unroll") for (int q = 0; q < 2; ++q) { vf[2 * q] = *(const LAS bf16x8*)(vb_ + r * VSTR + (16 * q + 8 * hh) * 2); vf[2 * q + 1] = *(const LAS bf16x8*)(vb_ + (32 + r) * VSTR + (16 * q + 8 * hh) * 2); } \
                _Pragma("unroll") for (int i = 0; i < 16; ++i) { SC0[i] = __builtin_amdgcn_exp2f(SC0[i] - m_run); SC1[i] = __builtin_amdgcn_exp2f(SC1[i] - m_run); ps += SC0[i]; ps += SC1[i]; } \
            } \
            if (!(FAST)) { l_run += ps; \
            asm volatile("" : "+v"(l_run)); }        \
            __builtin_amdgcn_sched_barrier(0); \
            __builtin_amdgcn_s_setprio(3); \
            _Pragma("unroll") for (int q = 2; q < 4; ++q) { vf[2 * q] = *(const LAS bf16x8*)(vb_ + r * VSTR + (16 * q + 8 * hh) * 2); vf[2 * q + 1] = *(const LAS bf16x8*)(vb_ + (32 + r) * VSTR + (16 * q + 8 * hh) * 2); } \
            _Pragma("unroll") for (int s = 0; s < 2; ++s) { \
                u32x4 pw; pw.x = pk2(SC0[8 * s], SC0[8 * s + 1]); pw.y = pk2(SC0[8 * s + 2], SC0[8 * s + 3]); pw.z = pk2(SC0[8 * s + 4], SC0[8 * s + 5]); pw.w = pk2(SC0[8 * s + 6], SC0[8 * s + 7]); \
                const bf16x8 pf = __builtin_bit_cast(bf16x8, pw); \
                o0 = MFMA32(vf[2 * s], pf, o0); o1 = MFMA32(vf[2 * s + 1], pf, o1); } \
            if (FAST) { _Pragma("unroll") for (int i = 8; i < 16; ++i) { SC1[i] = __builtin_amdgcn_exp2f(SC1[i]); ps += SC1[i]; }        \
                l_run += ps; asm volatile("" : "+v"(l_run)); } \
            _Pragma("unroll") for (int s = 0; s < 2; ++s) { \
                u32x4 pw; pw.x = pk2(SC1[8 * s], SC1[8 * s + 1]); pw.y = pk2(SC1[8 * s + 2], SC1[8 * s + 3]); pw.z = pk2(SC1[8 * s + 4], SC1[8 * s + 5]); pw.w = pk2(SC1[8 * s + 6], SC1[8 * s + 7]); \
                const bf16x8 pf = __builtin_bit_cast(bf16x8, pw); \
                o0 = MFMA32(vf[4 + 2 * s], pf, o0); o1 = MFMA32(vf[4 + 2 * s + 1], pf, o1); } \
            __builtin_amdgcn_s_setprio(0); \
            { LAS unsigned char* kd = Kl + bufc * KBUF; LAS unsigned char* vd = Vl + (bufc ^ 1) * VBUF; \
              *(LAS u32x4*)(kd + kw0) = WK0; *(LAS u32x2*)(kd + kw1) = WK1; \
              *(LAS u32x2*)(vd + vwl) = (u32x2){WV.x, WV.y}; *(LAS u32x2*)(vd + vwh) = (u32x2){WV.z, WV.w}; } \
            asm volatile("s_waitcnt lgkmcnt(0)" ::: "memory"); __builtin_amdgcn_s_barrier(); asm volatile("" ::: "memory");        \
            } while (0)
        {
#pragma unroll
            for (int i = 0; i < 16; ++i) { sA0[i] = 0.f; sA1[i] = 0.f; }
#pragma unroll
            for (int ks = 0; ks < 6; ++ks) {
                const bf16x8 ka = *(const LAS bf16x8*)(Kl + r * KSTR + ks * 32 + hh * 16);
                const bf16x8 kb2 = *(const LAS bf16x8*)(Kl + (32 + r) * KSTR + ks * 32 + hh * 16);
                sA0 = MFMA32(ka, qf[ks], sA0); sA1 = MFMA32(kb2, qf[ks], sA1);
            }
        }
        __syncthreads();
        u32x4 pa0 = (u32x4){0u, 0u, 0u, 0u}, pav = pa0; u32x2 pa1 = (u32x2){0u, 0u};
        if (fast) {
            for (int kt = 0; kt < nt; kt += 2) { ATT_STEP(kt, sA0, sA1, sB0, sB1, 1, pa0, pa1, pav, pa0, pa1, pav); ATT_STEP(kt + 1, sB0, sB1, sA0, sA1, 1, pa0, pa1, pav, pa0, pa1, pav); }
        } else {
            for (int kt = 0; kt < nt; kt += 2) { ATT_STEP(kt, sA0, sA1, sB0, sB1, 0, pa0, pa1, pav, pa0, pa1, pav); ATT_STEP(kt + 1, sB0, sB1, sA0, sA1, 0, pa0, pa1, pav, pa0, pa1, pav); }
        }
#undef ATT_STEP
#undef ATT_VF_QK
        const float lt = xor32_sum(l_run), inv = 1.0f / lt;
        bf16_t* op = MIX + (size_t)(qrow0 + wid * 32 + r) * 1024 + 512 + h * 64 + 4 * hh;
#pragma unroll
        for (int g = 0; g < 4; ++g) {
            u32x2 w0; w0.x = pk2(o0[4 * g] * inv, o0[4 * g + 1] * inv); w0.y = pk2(o0[4 * g + 2] * inv, o0[4 * g + 3] * inv);
            u32x2 w1; w1.x = pk2(o1[4 * g] * inv, o1[4 * g + 1] * inv); w1.y = pk2(o1[4 * g + 2] * inv, o1[4 * g + 3] * inv);
            *(u32x2*)(op + 8 * g) = w0; *(u32x2*)(op + 32 + 8 * g) = w1;
        }
    }
}

struct ConvRaw { u32x4 c0, c1, a0, a1, n0, n1; };
DI ConvRaw conv16_load(const bf16_t* U, size_t row, int col, bool hasp, bool hasn) {
    const bf16_t* p = U + row * UW + col;
    ConvRaw r; r.c0 = *(const u32x4*)p; r.c1 = *(const u32x4*)(p + 8);
    r.a0 = (u32x4){0u, 0u, 0u, 0u}; r.a1 = r.a0; r.n0 = r.a0; r.n1 = r.a0;
    if (hasp) { r.a0 = *(const u32x4*)(p - UW); r.a1 = *(const u32x4*)(p - UW + 8); }
    if (hasn) { r.n0 = *(const u32x4*)(p + UW); r.n1 = *(const u32x4*)(p + UW + 8); }
    return r;
}
DI void conv16_compute(const ConvRaw& r, const float* cw, const float* cb, int ch, float scale, float (&out)[16]) {
    const unsigned cu[8] = {r.c0.x, r.c0.y, r.c0.z, r.c0.w, r.c1.x, r.c1.y, r.c1.z, r.c1.w};
    const unsigned au[8] = {r.a0.x, r.a0.y, r.a0.z, r.a0.w, r.a1.x, r.a1.y, r.a1.z, r.a1.w};
    const unsigned nu[8] = {r.n0.x, r.n0.y, r.n0.z, r.n0.w, r.n1.x, r.n1.y, r.n1.z, r.n1.w};
    f32x4 w0[4], w1[4], w2[4], bb[4];
#pragma unroll
    for (int q = 0; q < 4; ++q) { w0[q] = *(const f32x4*)(cw + ch + 4 * q); w1[q] = *(const f32x4*)(cw + 512 + ch + 4 * q); w2[q] = *(const f32x4*)(cw + 1024 + ch + 4 * q); bb[q] = *(const f32x4*)(cb + ch + 4 * q); }
#pragma unroll
    for (int i = 0; i < 8; ++i) {
#pragma unroll
        for (int q = 0; q < 2; ++q) {
            const int k = 2 * i + q;
            const float xc = q ? __uint_as_float(cu[i] & 0xffff0000u) : __uint_as_float(cu[i] << 16);
            const float xa = q ? __uint_as_float(au[i] & 0xffff0000u) : __uint_as_float(au[i] << 16);
            const float xn = q ? __uint_as_float(nu[i] & 0xffff0000u) : __uint_as_float(nu[i] << 16);
            const float y = w0[k >> 2][k & 3] * xa + w1[k >> 2][k & 3] * xc + w2[k >> 2][k & 3] * xn + bb[k >> 2][k & 3];
            out[k] = silu_f(y) * scale;
        }
    }
}
DI void conv16(const bf16_t* U, size_t row, int col, bool hasp, bool hasn, const float* cw, const float* cb, int ch, float scale, float (&out)[16]) {
    const ConvRaw r = conv16_load(U, row, col, hasp, hasn); conv16_compute(r, cw, cb, ch, scale, out);
}

DI void mlstm_gates(const Args& a, int l, int h, float giraw, float gfraw, LAS float* logi, LAS float* logf, LAS float* bcum, LAS float* gg, LAS float* pmx, LAS float* sc) {
    const int tid = tidx();
    if (tid < 256) {
        const int dir = tid >> 7, s = tid & 127;
        const float gi = giraw + a.m_ib[l * 8 + dir * 4 + h];
        const float gf = gfraw + a.m_fb[l * 8 + dir * 4 + h];
        logi[dir * 128 + s] = gi;
        logf[dir * 128 + s] = fminf(gf, 0.f) - log1pf(expf(-fabsf(gf)));
    }
    __syncthreads();
    if (tid < 128) {
        const int dir = tid >> 6, ln = tid & 63;
        const int s0 = dir ? 127 - 2 * ln : 2 * ln, s1 = dir ? s0 - 1 : s0 + 1;
        const float f0 = logf[dir * 128 + s0], f1 = logf[dir * 128 + s1];
        float inc = f0 + f1;
#pragma unroll
        for (int o = 1; o < 64; o <<= 1) { const float v = __shfl_up(inc, o); if (ln >= o) inc += v; }
        const float exc = inc - (f0 + f1), b0 = exc + f0, b1 = exc + f0 + f1;
        const float g0 = logi[dir * 128 + s0] - b0, g1 = logi[dir * 128 + s1] - b1;
        float mi_ = fmaxf(g0, g1);
#pragma unroll
        for (int o = 1; o < 64; o <<= 1) { const float v = __shfl_up(mi_, o); if (ln >= o) mi_ = fmaxf(mi_, v); }
        float mex = __shfl_up(mi_, 1); if (ln == 0) mex = -1e30f;
        bcum[dir * 128 + s0] = b0; bcum[dir * 128 + s1] = b1; gg[dir * 128 + s0] = g0; gg[dir * 128 + s1] = g1;
        pmx[dir * 128 + s0] = fmaxf(mex, g0); pmx[dir * 128 + s1] = fmaxf(mex, fmaxf(g0, g1));
        if (ln == 63) { sc[dir * 4 + 0] = inc; sc[dir * 4 + 1] = mi_; }
    }
    __syncthreads();
}

DI void phase_mlstm_local(const Args& a, int l, LAS unsigned char* lds) {
    const int tid = tidx(), lane = tid & 63, wid = tid >> 6, r = lane & 31, hh = lane >> 5;
    constexpr int RS = 272;
    LAS unsigned char* KwT = lds;
    LAS unsigned char* VTl = lds + 2 * 64 * RS;
    LAS float* fl = (LAS float*)(lds + 3 * 64 * RS);
    LAS float* logi = fl, *logf = fl + 256, *bcum = fl + 512, *gg = fl + 768, *pmx = fl + 1024, *ww = fl + 1280, *sc = fl + 1536;
    const bf16_t* U = (const bf16_t*)(a.ws + WS_R1);
    float* MST = (float*)(a.ws + WS_R4 + R4_MST); float* MSC = (float*)(a.ws + WS_R4 + R4_MSC);
    const float* cw = a.m_conv_w + (size_t)l * 3 * 512; const float* cb = a.m_conv_b + (size_t)l * 512;
    const float* GT = (const float*)(a.ws + WS_R4 + R4_GATES);
    const int s = tid & 127, d0 = (tid >> 7) * 16;
    ConvRaw rk; u32x4 v0, v1; float giraw = 0.f, gfraw = 0.f;
#define ML_ISSUE(UN) do { \
        const int b_ = (UN) / (4 * NCHUNK), h_ = ((UN) / NCHUNK) % 4, j_ = (UN) % NCHUNK; \
        const size_t row0_ = (size_t)b_ * TPB + 128 * j_; \
        const bool hasp_ = !(s == 0 && (j_ == 0 || j_ == 2)), hasn_ = !(s == 127 && (j_ == 1 || j_ == NCHUNK - 1)); \
        rk = conv16_load(U, row0_ + s, U_K + 64 * h_ + d0, hasp_, hasn_); \
        const bf16_t* vp_ = U + (row0_ + s) * UW + U_V + 64 * h_ + d0; \
        v0 = *(const u32x4*)vp_; v1 = *(const u32x4*)(vp_ + 8); \
        if (tid < 256) { const int dir_ = tid >> 7; giraw = GT[(row0_ + s) * 16 + dir_ * 8 + h_]; gfraw = GT[(row0_ + s) * 16 + dir_ * 8 + 4 + h_]; } } while (0)
    int un = (bidx() + 128) % gdim();
    if (un < NB * 4 * NCHUNK) ML_ISSUE(un);
    for (; un < NB * 4 * NCHUNK; un += gdim()) {
        const int b = un / (4 * NCHUNK), h = (un / NCHUNK) % 4, j = un % NCHUNK;
        mlstm_gates(a, l, h, giraw, gfraw, logi, logf, bcum, gg, pmx, sc);
        if (tid < 256) { const int dir = tid >> 7; ww[tid] = expf(gg[tid] - sc[dir * 4 + 1]); }
        __syncthreads();
        {
            float kv[16];
            conv16_compute(rk, cw, cb, 256 + 64 * h + d0, 1.0f, kv);
            const float w0 = ww[s], w1 = ww[128 + s];
#pragma unroll
            for (int k = 0; k < 16; ++k) {
                *(LAS bf16_t*)(KwT + (d0 + k) * RS + s * 2) = f2bf(kv[k] * w0);
                *(LAS bf16_t*)(KwT + (64 + d0 + k) * RS + s * 2) = f2bf(kv[k] * w1);
            }
            const unsigned vu[8] = {v0.x, v0.y, v0.z, v0.w, v1.x, v1.y, v1.z, v1.w};
#pragma unroll
            for (int i = 0; i < 8; ++i) {
                *(LAS bf16_t*)(VTl + (d0 + 2 * i) * RS + s * 2) = (bf16_t)(vu[i] & 0xffffu);
                *(LAS bf16_t*)(VTl + (d0 + 2 * i + 1) * RS + s * 2) = (bf16_t)(vu[i] >> 16);
            }
        }
        if (un + gdim() < NB * 4 * NCHUNK) ML_ISSUE(un + gdim());
        __syncthreads();
        {
            const int dir = wid >> 2, eb = (wid >> 1) & 1, db = wid & 1;
            f32x16 acc;
#pragma unroll
            for (int i = 0; i < 16; ++i) acc[i] = 0.f;
#pragma unroll
            for (int ks = 0; ks < 8; ++ks) {
                const bf16x8 av = *(const LAS bf16x8*)(VTl + (32 * eb + r) * RS + ks * 32 + hh * 16);
                const bf16x8 bk = *(const LAS bf16x8*)(KwT + (dir * 64 + 32 * db + r) * RS + ks * 32 + hh * 16);
                acc = MFMA32(av, bk, acc);
            }
            const size_t rec = ((size_t)(b * 4 + h) * NCHUNK + j) * 2 + dir;
            float* dst = MST + rec * MREC;
#pragma unroll
            for (int i = 0; i < 16; ++i) dst[(32 * eb + crow(i, hh)) * 64 + 32 * db + r] = acc[i];
        }
        if (tid < 128) {
            const int dir = tid >> 6, d = tid & 63;
            const LAS bf16_t* kr = (const LAS bf16_t*)(KwT + (dir * 64 + d) * RS);
            float sum = 0.f;
            for (int s2 = 0; s2 < 128; ++s2) sum += bf2f(kr[s2]);
            const size_t rec = ((size_t)(b * 4 + h) * NCHUNK + j) * 2 + dir;
            MST[rec * MREC + 4096 + d] = sum;
            if (d == 0) { MSC[rec * 4 + 0] = sc[dir * 4 + 0] + sc[dir * 4 + 1]; MSC[rec * 4 + 1] = sc[dir * 4 + 0]; }
        }
        __syncthreads();
    }
#undef ML_ISSUE
}

DI void phase_mlstm_scan(const Args& a) {
    float* MST = (float*)(a.ws + WS_R4 + R4_MST); float* MSC = (float*)(a.ws + WS_R4 + R4_MSC); bf16_t* MSTB = (bf16_t*)(a.ws + WS_MSTB);
    const int tid = tidx();
    for (int blk = bidx(); blk < NB * 4 * 2 * 8; blk += gdim()) {
        const int seq = blk >> 3, el = (blk & 7) * NTHR + tid, dir = seq & 1, bh = seq >> 1;
        const bool ex = el < 64;
        float C = 0.f, C2 = 0.f, m = 0.f;
        for (int st0 = 0; st0 < NCHUNK; st0 += 11) {
            float loc[11], loc2[11], ml[11], bt[11];
#pragma unroll
            for (int q = 0; q < 11; ++q) {
                const int st = st0 + q, j = dir ? (st < 2 ? 1 - st : NCHUNK + 1 - st) : st;
                const size_t rec = ((size_t)bh * NCHUNK + j) * 2 + dir;
                loc[q] = MST[rec * MREC + el]; ml[q] = MSC[rec * 4 + 0]; bt[q] = MSC[rec * 4 + 1];
                loc2[q] = ex ? MST[rec * MREC + 4096 + el] : 0.f;
            }
#pragma unroll
            for (int q = 0; q < 11; ++q) {
                const int st = st0 + q, j = dir ? (st < 2 ? 1 - st : NCHUNK + 1 - st) : st;
                const size_t rec = ((size_t)bh * NCHUNK + j) * 2 + dir;
                MSTB[rec * 4096 + el] = f2bf(C);
                if (ex) MST[rec * MREC + 4096 + el] = C2;
                if (el == 0) MSC[rec * 4 + 2] = m;
                const float m_new = fmaxf(bt[q] + m, ml[q]);
                const float f1 = expf(bt[q] + m - m_new), f2 = expf(ml[q] - m_new);
                C = f1 * C + f2 * loc[q];
                C2 = f1 * C2 + f2 * loc2[q];
                m = m_new;
            }
        }
    }
}

DI void phase_mlstm_out(const Args& a, int l, LAS unsigned char* lds) {
    const int tid = tidx(), lane = tid & 63, wid = tid >> 6, r = lane & 31, hh = lane >> 5;
    constexpr int QS = 144, RS = 272;
    LAS unsigned char* Qs = lds;
    LAS unsigned char* Ks = Qs + 128 * QS;
    LAS unsigned char* VTl = Ks + 128 * QS;
    LAS unsigned char* Cs = VTl + 64 * RS;
    LAS float* fl = (LAS float*)(Cs + 2 * 64 * QS);
    LAS float* logi = fl, *logf = fl + 256, *bcum = fl + 512, *gg = fl + 768, *pmx = fl + 1024, *ns = fl + 1280  , *sc = fl + 1408  , *mi = fl + 1416  ;
    LAS float* Hb = fl + 1424;
    const bf16_t* U = (const bf16_t*)(a.ws + WS_R1); bf16_t* MIX = (bf16_t*)(a.ws + WS_XN);
    const float* MST = (const float*)(a.ws + WS_R4 + R4_MST); const float* MSC = (const float*)(a.ws + WS_R4 + R4_MSC);
    const float* cw = a.m_conv_w + (size_t)l * 3 * 512; const float* cb = a.m_conv_b + (size_t)l * 512;
    const int nun = (l < DEPTH - 1) ? NB * 4 * NCHUNK : NB * 4 * (NCHUNK - 2);
    for (int un = (bidx() + 128) % gdim(); un < nun; un += gdim()) {
        int b, h, j;
        if (l < DEPTH - 1) { b = un / (4 * NCHUNK); h = (un / NCHUNK) % 4; j = un % NCHUNK; }
        else { b = un / (4 * (NCHUNK - 2)); h = (un / (NCHUNK - 2)) % 4; j = 2 + un % (NCHUNK - 2); }
        const size_t row0 = (size_t)b * TPB + 128 * j;
        const size_t rec0 = ((size_t)(b * 4 + h) * NCHUNK + j) * 2;
        const int s = tid & 127, d0 = (tid >> 7) * 16;
        const bool hasp = !(s == 0 && (j == 0 || j == 2)), hasn = !(s == 127 && (j == 1 || j == NCHUNK - 1));
        const ConvRaw rq = conv16_load(U, row0 + s, U_Q + 64 * h + d0, hasp, hasn), rk = conv16_load(U, row0 + s, U_K + 64 * h + d0, hasp, hasn);
        const bf16_t* vp = U + (row0 + s) * UW + U_V + 64 * h + d0;
        const u32x4 v0 = *(const u32x4*)vp, v1 = *(const u32x4*)(vp + 8);
        const int cdir = tid >> 8, ce = (tid >> 2) & 63, cd0 = (tid & 3) * 16;
        const float* cp = MST + (rec0 + cdir) * MREC + ce * 64 + cd0;
        const f32x4 c0 = *(const f32x4*)cp, c1 = *(const f32x4*)(cp + 4), c2 = *(const f32x4*)(cp + 8), c3 = *(const f32x4*)(cp + 12);
        { const float* GT_ = (const float*)(a.ws + WS_R4 + R4_GATES); float gi_ = 0.f, gf_ = 0.f;
          if (tid < 256) { const int dir_ = tid >> 7, s_ = tid & 127; gi_ = GT_[(row0 + s_) * 16 + dir_ * 8 + h]; gf_ = GT_[(row0 + s_) * 16 + dir_ * 8 + 4 + h]; }
          mlstm_gates(a, l, h, gi_, gf_, logi, logf, bcum, gg, pmx, sc); }
        {
            float tv[16];
            conv16_compute(rq, cw, cb, 64 * h + d0, 0.125f, tv);
            { u32x4 w0, w1; w0.x = pk2(tv[0], tv[1]); w0.y = pk2(tv[2], tv[3]); w0.z = pk2(tv[4], tv[5]); w0.w = pk2(tv[6], tv[7]); w1.x = pk2(tv[8], tv[9]); w1.y = pk2(tv[10], tv[11]); w1.z = pk2(tv[12], tv[13]); w1.w = pk2(tv[14], tv[15]);
              *(LAS u32x4*)(Qs + s * QS + d0 * 2) = w0; *(LAS u32x4*)(Qs + s * QS + d0 * 2 + 16) = w1; }
            conv16_compute(rk, cw, cb, 256 + 64 * h + d0, 1.0f, tv);
            { u32x4 w0, w1; w0.x = pk2(tv[0], tv[1]); w0.y = pk2(tv[2], tv[3]); w0.z = pk2(tv[4], tv[5]); w0.w = pk2(tv[6], tv[7]); w1.x = pk2(tv[8], tv[9]); w1.y = pk2(tv[10], tv[11]); w1.z = pk2(tv[12], tv[13]); w1.w = pk2(tv[14], tv[15]);
              *(LAS u32x4*)(Ks + s * QS + d0 * 2) = w0; *(LAS u32x4*)(Ks + s * QS + d0 * 2 + 16) = w1; }
            const unsigned vu[8] = {v0.x, v0.y, v0.z, v0.w, v1.x, v1.y, v1.z, v1.w};
#pragma unroll
            for (int i = 0; i < 8; ++i) {
                *(LAS bf16_t*)(VTl + (d0 + 2 * i) * RS + s * 2) = (bf16_t)(vu[i] & 0xffffu);
                *(LAS bf16_t*)(VTl + (d0 + 2 * i + 1) * RS + s * 2) = (bf16_t)(vu[i] >> 16);
            }
            u32x4 w0, w1; w0.x = pk2(c0[0], c0[1]); w0.y = pk2(c0[2], c0[3]); w0.z = pk2(c1[0], c1[1]); w0.w = pk2(c1[2], c1[3]); w1.x = pk2(c2[0], c2[1]); w1.y = pk2(c2[2], c2[3]); w1.z = pk2(c3[0], c3[1]); w1.w = pk2(c3[2], c3[3]);
            *(LAS u32x4*)(Cs + (cdir * 64 + ce) * QS + cd0 * 2) = w0; *(LAS u32x4*)(Cs + (cdir * 64 + ce) * QS + cd0 * 2 + 16) = w1;
            if (tid < 128) ns[tid] = MST[(rec0 + (tid >> 6)) * MREC + 4096 + (tid & 63)];
            if (tid < 2) mi[tid] = MSC[(rec0 + tid) * 4 + 2];
        }
        __syncthreads();
        const int dir = wid >> 2, tb = wid & 3, t = 32 * tb + r;
        const float m_in = mi[dir];
        const float Mt = fmaxf(m_in, pmx[dir * 128 + t]);
        const float a_t = expf(m_in - Mt);
        bf16x8 qf[4];
#pragma unroll
        for (int ks = 0; ks < 4; ++ks) qf[ks] = *(const LAS bf16x8*)(Qs + t * QS + ks * 32 + hh * 16);
        f32x16 o0, o1;
#pragma unroll
        for (int i = 0; i < 16; ++i) { o0[i] = 0.f; o1[i] = 0.f; }
        float qn = 0.f;
#pragma unroll
        for (int ks = 0; ks < 4; ++ks) {
            const bf16x8 c0 = *(const LAS bf16x8*)(Cs + (dir * 64 + r) * QS + ks * 32 + hh * 16);
            const bf16x8 c1 = *(const LAS bf16x8*)(Cs + (dir * 64 + 32 + r) * QS + ks * 32 + hh * 16);
            o0 = MFMA32(c0, qf[ks], o0); o1 = MFMA32(c1, qf[ks], o1);
#pragma unroll
            for (int jx = 0; jx < 8; ++jx) qn += bf2f((bf16_t)qf[ks][jx]) * ns[dir * 64 + ks * 16 + hh * 8 + jx];
        }
        qn = xor32_sum(qn);
#pragma unroll
        for (int i = 0; i < 16; ++i) { o0[i] *= a_t; o1[i] *= a_t; }
        float rs = 0.f;
        const int sb_lo = dir ? tb : 0, sb_hi = dir ? 3 : tb;
        for (int sb = sb_lo; sb <= sb_hi; ++sb) {
            f32x16 sv;
#pragma unroll
            for (int i = 0; i < 16; ++i) sv[i] = 0.f;
#pragma unroll
            for (int ks = 0; ks < 4; ++ks) {
                const bf16x8 ka = *(const LAS bf16x8*)(Ks + (32 * sb + r) * QS + ks * 32 + hh * 16);
                sv = MFMA32(ka, qf[ks], sv);
            }
#pragma unroll
            for (int i = 0; i < 16; ++i) {
                const int s = 32 * sb + crow(i, hh);
                const bool valid = dir ? (s >= t) : (s <= t);
                const float wgt = valid ? expf(gg[dir * 128 + s] - Mt) : 0.f;
                sv[i] *= wgt; rs += sv[i];
            }
#pragma unroll
            for (int ss = 0; ss < 2; ++ss) {
                u32x4 pw; pw.x = pk2(sv[8 * ss], sv[8 * ss + 1]); pw.y = pk2(sv[8 * ss + 2], sv[8 * ss + 3]); pw.z = pk2(sv[8 * ss + 4], sv[8 * ss + 5]); pw.w = pk2(sv[8 * ss + 6], sv[8 * ss + 7]);
                const bf16x8 pf = __builtin_bit_cast(bf16x8, pw);
                const int koff = (32 * sb + 16 * ss + 4 * hh) * 2;
                const s16x4 va0 = *(const LAS s16x4*)(VTl + r * RS + koff), va1 = *(const LAS s16x4*)(VTl + r * RS + koff + 16);
                const s16x4 vb0 = *(const LAS s16x4*)(VTl + (32 + r) * RS + koff), vb1 = *(const LAS s16x4*)(VTl + (32 + r) * RS + koff + 16);
                o0 = MFMA32(__builtin_shufflevector(va0, va1, 0, 1, 2, 3, 4, 5, 6, 7), pf, o0);
                o1 = MFMA32(__builtin_shufflevector(vb0, vb1, 0, 1, 2, 3, 4, 5, 6, 7), pf, o1);
            }
        }
        rs = xor32_sum(rs);
        const float den = a_t * qn + rs, mt = bcum[dir * 128 + t] + Mt;
        const float dd = 1.0f / fmaxf(fabsf(den), expf(-mt));
#pragma unroll
        for (int i = 0; i < 16; ++i) { o0[i] *= dd; o1[i] *= dd; }
        if (dir == 1) {
#pragma unroll
            for (int i = 0; i < 16; ++i) { Hb[t * 65 + crow(i, hh)] = o0[i]; Hb[t * 65 + 32 + crow(i, hh)] = o1[i]; }
        }
        __syncthreads();
        if (dir == 0) {
            float ssq = 0.f;
#pragma unroll
            for (int i = 0; i < 16; ++i) { o0[i] += Hb[t * 65 + crow(i, hh)]; o1[i] += Hb[t * 65 + 32 + crow(i, hh)]; ssq += o0[i] * o0[i] + o1[i] * o1[i]; }
            ssq = xor32_sum(ssq);
            const float rstd = rsqrtf(ssq * (1.0f / 64.0f) + EPS);
            const float* gn = a.m_norm_g + (size_t)l * 256 + 64 * h;
            const bf16_t* og = U + (row0 + t) * UW + U_O + 64 * h;
            bf16_t* op = MIX + (row0 + t) * 1024 + 256 + 64 * h;
#pragma unroll
            for (int g = 0; g < 4; ++g) {
#pragma unroll
                for (int eb = 0; eb < 2; ++eb) {
                    const int e0 = 32 * eb + 8 * g + 4 * hh;
                    const u32x2 ow = *(const u32x2*)(og + e0);
                    const float og0 = __uint_as_float(ow.x << 16), og1 = __uint_as_float(ow.x & 0xffff0000u), og2 = __uint_as_float(ow.y << 16), og3 = __uint_as_float(ow.y & 0xffff0000u);
                    const float h0 = (eb ? o1[4 * g] : o0[4 * g]), h1 = (eb ? o1[4 * g + 1] : o0[4 * g + 1]), h2 = (eb ? o1[4 * g + 2] : o0[4 * g + 2]), h3 = (eb ? o1[4 * g + 3] : o0[4 * g + 3]);
                    u32x2 w; w.x = pk2(h0 * rstd * gn[e0] * sigmoid_f(og0), h1 * rstd * gn[e0 + 1] * sigmoid_f(og1));
                    w.y = pk2(h2 * rstd * gn[e0 + 2] * sigmoid_f(og2), h3 * rstd * gn[e0 + 3] * sigmoid_f(og3));
                    *(u32x2*)(op + e0) = w;
                }
            }
        }
        __syncthreads();
    }
}

DI void mlstm_gates_half(const Args& a, int l, int h, size_t row0, int ht, LAS float* logi, LAS float* logf, LAS float* bcum, LAS float* gg, LAS float* pmx, LAS float* sc) {
    const float* GT = (const float*)(a.ws + WS_R4 + R4_GATES);
    {
        const int dir = ht >> 7, s = ht & 127;
        const float gi = GT[(row0 + s) * 16 + dir * 8 + h] + a.m_ib[l * 8 + dir * 4 + h];
        const float gf = GT[(row0 + s) * 16 + dir * 8 + 4 + h] + a.m_fb[l * 8 + dir * 4 + h];
        logi[dir * 128 + s] = gi;
        logf[dir * 128 + s] = fminf(gf, 0.f) - log1pf(expf(-fabsf(gf)));
    }
    __syncthreads();
    if (ht < 128) {
        const int dir = ht >> 6, ln = ht & 63;
        const int s0 = dir ? 127 - 2 * ln : 2 * ln, s1 = dir ? s0 - 1 : s0 + 1;
        const float f0 = logf[dir * 128 + s0], f1 = logf[dir * 128 + s1];
        float inc = f0 + f1;
#pragma unroll
        for (int o = 1; o < 64; o <<= 1) { const float v = __shfl_up(inc, o); if (ln >= o) inc += v; }
        const float exc = inc - (f0 + f1), b0 = exc + f0, b1 = exc + f0 + f1;
        const float g0 = logi[dir * 128 + s0] - b0, g1 = logi[dir * 128 + s1] - b1;
        float mi_ = fmaxf(g0, g1);
#pragma unroll
        for (int o = 1; o < 64; o <<= 1) { const float v = __shfl_up(mi_, o); if (ln >= o) mi_ = fmaxf(mi_, v); }
        float mex = __shfl_up(mi_, 1); if (ln == 0) mex = -1e30f;
        bcum[dir * 128 + s0] = b0; bcum[dir * 128 + s1] = b1; gg[dir * 128 + s0] = g0; gg[dir * 128 + s1] = g1;
        pmx[dir * 128 + s0] = fmaxf(mex, g0); pmx[dir * 128 + s1] = fmaxf(mex, fmaxf(g0, g1));
        if (ln == 63) { sc[dir * 4 + 0] = inc; sc[dir * 4 + 1] = mi_; }
    }
    __syncthreads();
}

DI void phase_mlstm_out2(const Args& a, int l, LAS unsigned char* lds) {
    const int tid = tidx(), lane = tid & 63, wid = tid >> 6, r = lane & 31, hh = lane >> 5;
    const int half = wid >> 2, tb = wid & 3, ht = tid & 255;
    constexpr int QS = 144, RS = 272, HB = 78848;
    LAS unsigned char* hb = lds + half * HB;
    LAS unsigned char* Qs = hb;
    LAS unsigned char* Ks = Qs + 128 * QS;
    LAS unsigned char* VTl = Ks + 128 * QS;
    LAS unsigned char* Cs = VTl + 64 * RS;
    LAS float* fl = (LAS float*)(Cs + 2 * 64 * QS);
    LAS float* logi = fl, *logf = fl + 256, *bcum = fl + 512, *gg = fl + 768, *pmx = fl + 1024, *ns = fl + 1280  , *sc = fl + 1408  , *mi = fl + 1416  ;
    const bf16_t* U = (const bf16_t*)(a.ws + WS_R1); bf16_t* MIX = (bf16_t*)(a.ws + WS_XN);
    const float* MST = (const float*)(a.ws + WS_R4 + R4_MST); const float* MSC = (const float*)(a.ws + WS_R4 + R4_MSC);
    const float* cw = a.m_conv_w + (size_t)l * 3 * 512; const float* cb = a.m_conv_b + (size_t)l * 512;
    const int nun = (l < DEPTH - 1) ? NB * 4 * NCHUNK : NB * 4 * (NCHUNK - 2);
    for (int pi = (bidx() + 128) % gdim(); 2 * pi < nun; pi += gdim()) {
        const int un = 2 * pi + half;
        int b, h, j;
        if (l < DEPTH - 1) { b = un / (4 * NCHUNK); h = (un / NCHUNK) % 4; j = un % NCHUNK; }
        else { b = un / (4 * (NCHUNK - 2)); h = (un / (NCHUNK - 2)) % 4; j = 2 + un % (NCHUNK - 2); }
        const size_t row0 = (size_t)b * TPB + 128 * j;
        const size_t rec0 = ((size_t)(b * 4 + h) * NCHUNK + j) * 2;
        const int s = ht & 127, dq = (ht >> 7) * 32;
        const bool hasp = !(s == 0 && (j == 0 || j == 2)), hasn = !(s == 127 && (j == 1 || j == NCHUNK - 1));
        const ConvRaw rq0 = conv16_load(U, row0 + s, U_Q + 64 * h + dq, hasp, hasn), rk0 = conv16_load(U, row0 + s, U_K + 64 * h + dq, hasp, hasn);
        const bf16_t* vp = U + (row0 + s) * UW + U_V + 64 * h + dq;
        const u32x4 v0 = *(const u32x4*)vp, v1 = *(const u32x4*)(vp + 8), v2 = *(const u32x4*)(vp + 16), v3 = *(const u32x4*)(vp + 24);
        mlstm_gates_half(a, l, h, row0, ht, logi, logf, bcum, gg, pmx, sc);
        {
            const int cdir = ht >> 7, ce = (ht >> 1) & 63, cd0 = (ht & 1) * 32;
            const bf16_t* cp = (const bf16_t*)(a.ws + WS_MSTB) + (rec0 + cdir) * 4096 + ce * 64 + cd0;
            u32x4 cc[4];
#pragma unroll
            for (int q = 0; q < 4; ++q) cc[q] = *(const u32x4*)(cp + 8 * q);
            const float nsv = (ht < 128) ? MST[(rec0 + (ht >> 6)) * MREC + 4096 + (ht & 63)] : 0.f;
            const float miv = (ht < 2) ? MSC[(rec0 + ht) * 4 + 2] : 0.f;
            asm volatile("" ::: "memory");
            float tv[16];
#pragma unroll
            for (int ps = 0; ps < 2; ++ps) {
                ConvRaw rq1 = rq0, rk1 = rk0;
                if (ps) { asm volatile("" ::: "memory"); rq1 = conv16_load(U, row0 + s, U_Q + 64 * h + dq + 16, hasp, hasn); rk1 = conv16_load(U, row0 + s, U_K + 64 * h + dq + 16, hasp, hasn); }
                conv16_compute(rq1, cw, cb, 64 * h + dq + 16 * ps, 0.125f, tv);
                { u32x4 w0, w1; w0.x = pk2(tv[0], tv[1]); w0.y = pk2(tv[2], tv[3]); w0.z = pk2(tv[4], tv[5]); w0.w = pk2(tv[6], tv[7]); w1.x = pk2(tv[8], tv[9]); w1.y = pk2(tv[10], tv[11]); w1.z = pk2(tv[12], tv[13]); w1.w = pk2(tv[14], tv[15]);
                  *(LAS u32x4*)(Qs + s * QS + (dq + 16 * ps) * 2) = w0; *(LAS u32x4*)(Qs + s * QS + (dq + 16 * ps) * 2 + 16) = w1; }
                conv16_compute(rk1, cw, cb, 256 + 64 * h + dq + 16 * ps, 1.0f, tv);
                { u32x4 w0, w1; w0.x = pk2(tv[0], tv[1]); w0.y = pk2(tv[2], tv[3]); w0.z = pk2(tv[4], tv[5]); w0.w = pk2(tv[6], tv[7]); w1.x = pk2(tv[8], tv[9]); w1.y = pk2(tv[10], tv[11]); w1.z = pk2(tv[12], tv[13]); w1.w = pk2(tv[14], tv[15]);
                  *(LAS u32x4*)(Ks + s * QS + (dq + 16 * ps) * 2) = w0; *(LAS u32x4*)(Ks + s * QS + (dq + 16 * ps) * 2 + 16) = w1; }
            }
            const unsigned vu[16] = {v0.x, v0.y, v0.z, v0.w, v1.x, v1.y, v1.z, v1.w, v2.x, v2.y, v2.z, v2.w, v3.x, v3.y, v3.z, v3.w};
#pragma unroll
            for (int i = 0; i < 16; ++i) {
                *(LAS bf16_t*)(VTl + (dq + 2 * i) * RS + s * 2) = (bf16_t)(vu[i] & 0xffffu);
                *(LAS bf16_t*)(VTl + (dq + 2 * i + 1) * RS + s * 2) = (bf16_t)(vu[i] >> 16);
            }
#pragma unroll
            for (int q = 0; q < 4; ++q)
                *(LAS u32x4*)(Cs + (cdir * 64 + ce) * QS + (cd0 + 8 * q) * 2) = cc[q];
            if (ht < 128) ns[ht] = nsv;
            if (ht < 2) mi[ht] = miv;
        }
        __syncthreads();
        const int t = 32 * tb + r;
        bf16x8 qf[4];
#pragma unroll
        for (int ks = 0; ks < 4; ++ks) qf[ks] = *(const LAS bf16x8*)(Qs + t * QS + ks * 32 + hh * 16);
        f32x16 hs0, hs1;
#pragma unroll
        for (int i = 0; i < 16; ++i) { hs0[i] = 0.f; hs1[i] = 0.f; }
        u32x2 ogw[4][2];
        { const bf16_t* og = U + (row0 + t) * UW + U_O + 64 * h;
#pragma unroll
          for (int g = 0; g < 4; ++g)
#pragma unroll
              for (int eb = 0; eb < 2; ++eb) ogw[g][eb] = *(const u32x2*)(og + 32 * eb + 8 * g + 4 * hh); }
#pragma unroll
        for (int dir = 0; dir < 2; ++dir) {
            const float m_in = mi[dir];
            const float Mt = fmaxf(m_in, pmx[dir * 128 + t]);
            const float a_t = expf(m_in - Mt);
            f32x16 o0, o1;
#pragma unroll
            for (int i = 0; i < 16; ++i) { o0[i] = 0.f; o1[i] = 0.f; }
            float qn = 0.f;
#pragma unroll
            for (int ks = 0; ks < 4; ++ks) {
                const bf16x8 c0 = *(const LAS bf16x8*)(Cs + (dir * 64 + r) * QS + ks * 32 + hh * 16);
                const bf16x8 c1 = *(const LAS bf16x8*)(Cs + (dir * 64 + 32 + r) * QS + ks * 32 + hh * 16);
                o0 = MFMA32(c0, qf[ks], o0); o1 = MFMA32(c1, qf[ks], o1);
#pragma unroll
                for (int jx = 0; jx < 8; ++jx) qn += bf2f((bf16_t)qf[ks][jx]) * ns[dir * 64 + ks * 16 + hh * 8 + jx];
            }
            qn = xor32_sum(qn);
#pragma unroll
            for (int i = 0; i < 16; ++i) { o0[i] *= a_t; o1[i] *= a_t; }
            float rs = 0.f;
            const int sb_lo = dir ? tb : 0, sb_hi = dir ? 3 : tb;
            for (int sb = sb_lo; sb <= sb_hi; ++sb) {
                f32x16 sv;
#pragma unroll
                for (int i = 0; i < 16; ++i) sv[i] = 0.f;
#pragma unroll
                for (int ks = 0; ks < 4; ++ks) {
                    const bf16x8 ka = *(const LAS bf16x8*)(Ks + (32 * sb + r) * QS + ks * 32 + hh * 16);
                    sv = MFMA32(ka, qf[ks], sv);
                }
#pragma unroll
                for (int i = 0; i < 16; ++i) {
                    const int sx = 32 * sb + crow(i, hh);
                    const bool valid = dir ? (sx >= t) : (sx <= t);
                    const float wgt = valid ? __expf(gg[dir * 128 + sx] - Mt) : 0.f;
                    sv[i] *= wgt; rs += sv[i];
                }
#pragma unroll
                for (int ss = 0; ss < 2; ++ss) {
                    u32x4 pw; pw.x = pk2(sv[8 * ss], sv[8 * ss + 1]); pw.y = pk2(sv[8 * ss + 2], sv[8 * ss + 3]); pw.z = pk2(sv[8 * ss + 4], sv[8 * ss + 5]); pw.w = pk2(sv[8 * ss + 6], sv[8 * ss + 7]);
                    const bf16x8 pf = __builtin_bit_cast(bf16x8, pw);
                    const int koff = (32 * sb + 16 * ss + 4 * hh) * 2;
                    const s16x4 va0 = *(const LAS s16x4*)(VTl + r * RS + koff), va1 = *(const LAS s16x4*)(VTl + r * RS + koff + 16);
                    const s16x4 vb0 = *(const LAS s16x4*)(VTl + (32 + r) * RS + koff), vb1 = *(const LAS s16x4*)(VTl + (32 + r) * RS + koff + 16);
                    o0 = MFMA32(__builtin_shufflevector(va0, va1, 0, 1, 2, 3, 4, 5, 6, 7), pf, o0);
                    o1 = MFMA32(__builtin_shufflevector(vb0, vb1, 0, 1, 2, 3, 4, 5, 6, 7), pf, o1);
                }
            }
            rs = xor32_sum(rs);
            const float den = a_t * qn + rs, mt = bcum[dir * 128 + t] + Mt;
            const float dd = 1.0f / fmaxf(fabsf(den), expf(-mt));
#pragma unroll
            for (int i = 0; i < 16; ++i) { hs0[i] += o0[i] * dd; hs1[i] += o1[i] * dd; }
        }
        {
            float ssq = 0.f;
#pragma unroll
            for (int i = 0; i < 16; ++i) ssq += hs0[i] * hs0[i] + hs1[i] * hs1[i];
            ssq = xor32_sum(ssq);
            const float rstd = rsqrtf(ssq * (1.0f / 64.0f) + EPS);
            const float* gn = a.m_norm_g + (size_t)l * 256 + 64 * h;
            bf16_t* op = MIX + (row0 + t) * 1024 + 256 + 64 * h;
#pragma unroll
            for (int g = 0; g < 4; ++g) {
#pragma unroll
                for (int eb = 0; eb < 2; ++eb) {
                    const int e0 = 32 * eb + 8 * g + 4 * hh;
                    const u32x2 ow = ogw[g][eb];
                    const float og0 = __uint_as_float(ow.x << 16), og1 = __uint_as_float(ow.x & 0xffff0000u), og2 = __uint_as_float(ow.y << 16), og3 = __uint_as_float(ow.y & 0xffff0000u);
                    const float h0 = (eb ? hs1[4 * g] : hs0[4 * g]), h1 = (eb ? hs1[4 * g + 1] : hs0[4 * g + 1]), h2 = (eb ? hs1[4 * g + 2] : hs0[4 * g + 2]), h3 = (eb ? hs1[4 * g + 3] : hs0[4 * g + 3]);
                    u32x2 w; w.x = pk2(h0 * rstd * gn[e0] * sigmoid_f(og0), h1 * rstd * gn[e0 + 1] * sigmoid_f(og1));
                    w.y = pk2(h2 * rstd * gn[e0 + 2] * sigmoid_f(og2), h3 * rstd * gn[e0 + 3] * sigmoid_f(og3));
                    *(u32x2*)(op + e0) = w;
                }
            }
        }
        __syncthreads();
    }
}
DI void phase_fft_a(const Args& a, LAS unsigned char* lds) {
    const int tid = tidx(), lane = tid & 63, wid = tid >> 6, r = lane & 31, hh = lane >> 5;
    constexpr int RS = 272;
    LAS unsigned char* WAs = lds;
    LAS unsigned char* Fs = lds + 256 * RS;
    const bf16_t* WA = (const bf16_t*)(a.ws + WS_WA);
    for (int i = tid; i < 256 * 16; i += NTHR) { const int m = i >> 4, ch = i & 15; *(LAS u32x4*)(WAs + m * RS + ch * 16) = *(const u32x4*)(WA + m * 128 + ch * 8); }
    const bf16_t* U = (const bf16_t*)(a.ws + WS_R1); unsigned* FI = (unsigned*)(a.ws + WS_R4 + R4_FFTI);
    const f32x2* TW = (const f32x2*)(a.ws + WS_TW);
    for (int un = bidx(); un < NB * 64; un += gdim()) {
        const int b = un >> 6, cq = un & 63;
        __syncthreads();
        u32x2 wst[16];
#pragma unroll
        for (int i = 0; i < 16; ++i) { const int t = tid + NTHR * i; wst[i] = *(const u32x2*)(U + ((size_t)b * TPB + CTXL + t) * UW + U_F + 4 * cq); }
#pragma unroll
        for (int i = 0; i < 16; ++i) {
            const int t = tid + NTHR * i, t1 = t >> 6, t2 = t & 63;
            const u32x2 w = wst[i];
            *(LAS bf16_t*)(Fs + (0 * 64 + t2) * RS + t1 * 2) = (bf16_t)(w.x & 0xffffu);
            *(LAS bf16_t*)(Fs + (1 * 64 + t2) * RS + t1 * 2) = (bf16_t)(w.x >> 16);
            *(LAS bf16_t*)(Fs + (2 * 64 + t2) * RS + t1 * 2) = (bf16_t)(w.y & 0xffffu);
            *(LAS bf16_t*)(Fs + (3 * 64 + t2) * RS + t1 * 2) = (bf16_t)(w.y >> 16);
        }
        __syncthreads();
        const int c = wid >> 1, t2 = 32 * (wid & 1) + r;
        bf16x8 bfr[8];
#pragma unroll
        for (int ks = 0; ks < 8; ++ks) bfr[ks] = *(const LAS bf16x8*)(Fs + (c * 64 + t2) * RS + ks * 32 + hh * 16);
        for (int kb = 0; kb < 4; ++kb) {
            f32x16 re, im;
#pragma unroll
            for (int i = 0; i < 16; ++i) { re[i] = 0.f; im[i] = 0.f; }
#pragma unroll
            for (int ks = 0; ks < 8; ++ks) {
                const bf16x8 ar = *(const LAS bf16x8*)(WAs + (32 * kb + r) * RS + ks * 32 + hh * 16);
                const bf16x8 ai = *(const LAS bf16x8*)(WAs + (128 + 32 * kb + r) * RS + ks * 32 + hh * 16);
                re = MFMA32(ar, bfr[ks], re); im = MFMA32(ai, bfr[ks], im);
            }
#pragma unroll
            for (int i = 0; i < 16; ++i) {
                const int k1 = 32 * kb + crow(i, hh);
                const f32x2 cs = TW[(k1 * t2) & 8191];
                const float ore = re[i] * cs.x + im[i] * cs.y, oim = im[i] * cs.x - re[i] * cs.y;
                FI[((size_t)(b * 128 + k1) * 256 + 4 * cq + c) * 64 + t2] = pk2(ore, oim);
            }
        }
    }
    __syncthreads();
}

DI void phase_fft_bc(const Args& a, LAS unsigned char* lds, int nheavy = 0, int heavy_idx = -1, int light_idx = -1) {
    const int tid = tidx(), lane = tid & 63, wid = tid >> 6, r = lane & 31, hh = lane >> 5;
    constexpr int RS = 272, GS = 528;
    LAS unsigned char* WBs = lds;
    LAS unsigned char* WCs = lds + 128 * RS;
    LAS unsigned char* Gs = WCs + 64 * RS;
    const bf16_t* WB = (const bf16_t*)(a.ws + WS_WB); const bf16_t* WC = (const bf16_t*)(a.ws + WS_WC);
    for (int i = tid; i < 128 * 16; i += NTHR) { const int m = i >> 4, ch = i & 15; *(LAS u32x4*)(WBs + m * RS + ch * 16) = *(const u32x4*)(WB + m * 128 + ch * 8); }
    for (int i = tid; i < 64 * 16; i += NTHR) { const int m = i >> 4, ch = i & 15; *(LAS u32x4*)(WCs + m * RS + ch * 16) = *(const u32x4*)(WC + m * 128 + ch * 8); }
    const bf16_t* FI = (const bf16_t*)(a.ws + WS_R4 + R4_FFTI); bf16_t* MIX = (bf16_t*)(a.ws + WS_XN);
    const float oscale = 0.001381067932004976f;
    const int nlight = gdim() - nheavy, nreg = (nheavy > 0) ? (NB * 128 - nheavy) : NB * 128;
    int un = (nheavy > 0) ? ((heavy_idx >= 0) ? nreg + heavy_idx : light_idx) : bidx();
    const int ustep = (nheavy > 0) ? nlight : gdim(), ulim = (nheavy > 0 && heavy_idx >= 0) ? NB * 128 : nreg;
    for (; un < ulim; un += (nheavy > 0 && heavy_idx >= 0) ? NB * 128 : ustep) {
        const int b = un >> 7, k1 = un & 127;
        __syncthreads();
        {
            const int c = 32 * wid + r;
            const bf16_t* ip = FI + ((size_t)(b * 128 + k1) * 256 + c) * 128 + 8 * hh;
            bf16x8 bfr[8];
#pragma unroll
            for (int ks = 0; ks < 8; ++ks) bfr[ks] = *(const bf16x8*)(ip + 16 * ks);
            for (int mb = 0; mb < 4; ++mb) {
                f32x16 acc;
#pragma unroll
                for (int i = 0; i < 16; ++i) acc[i] = 0.f;
#pragma unroll
                for (int ks = 0; ks < 8; ++ks) {
                    const bf16x8 aw = *(const LAS bf16x8*)(WBs + (32 * mb + r) * RS + ks * 32 + hh * 16);
                    acc = MFMA32(aw, bfr[ks], acc);
                }
#pragma unroll
                for (int i = 0; i < 16; ++i) *(LAS bf16_t*)(Gs + (32 * mb + crow(i, hh)) * GS + c * 2) = f2bf(acc[i]);
            }
        }
        __syncthreads();
        {
            const int g = wid >> 1, lb = wid & 1;
            bf16x8 wf[8];
#pragma unroll
            for (int ks = 0; ks < 8; ++ks) wf[ks] = *(const LAS bf16x8*)(WCs + (32 * lb + r) * RS + ks * 32 + hh * 16);
            for (int kb2 = 0; kb2 < 2; ++kb2) {
                f32x16 acc;
#pragma unroll
                for (int i = 0; i < 16; ++i) acc[i] = 0.f;
#pragma unroll
                for (int ks = 0; ks < 8; ++ks) {
                    const int ri = ks >> 2;
                    const bf16x8 ag = *(const LAS bf16x8*)(Gs + (ri * 64 + 32 * kb2 + r) * GS + (g * 64 + 16 * (ks & 3) + 8 * hh) * 2);
                    acc = MFMA32(ag, wf[ks], acc);
                }
#pragma unroll
                for (int i = 0; i < 16; ++i) {
                    const int k2 = 32 * kb2 + crow(i, hh);
                    MIX[((size_t)b * TPB + CTXL + k1 + 128 * k2) * 1024 + g * 64 + 32 * lb + r] = f2bf(acc[i] * oscale);
                }
            }
        }
    }
    __syncthreads();
}

DI void phase_cfft(const Args& a, LAS unsigned char* lds) {
    const int tid = tidx();
    const bf16_t* U = (const bf16_t*)(a.ws + WS_R1); const f32x2* TW = (const f32x2*)(a.ws + WS_TW); bf16_t* MIX = (bf16_t*)(a.ws + WS_XN);
    LAS f32x2* tw = (LAS f32x2*)lds;
    LAS f32x2* T = tw + 256;
    LAS unsigned char* Fs = lds + 2048 + 16384;
    LAS f32x2* Gs = (LAS f32x2*)Fs;
    __syncthreads();
    if (tid < 256) tw[tid] = TW[tid * 32];
    for (int un = bidx(); un < NB * 32; un += gdim()) {
        const int b = un >> 5, kb = 8 * (un & 31);
        __syncthreads();
        {
            u32x4 rr[16];
#pragma unroll
            for (int i = 0; i < 16; ++i) { const int ch = tid + 512 * i, t = ch >> 5, cc = (ch & 31) * 8; rr[i] = *(const u32x4*)(U + ((size_t)b * TPB + t) * UW + U_F + cc); }
#pragma unroll
            for (int i = 0; i < 4; ++i) { const int idx = tid + 512 * i, t = idx >> 3, q = idx & 7; T[idx] = tw[((kb + q) * t) & 255]; }
#pragma unroll
            for (int i = 0; i < 16; ++i) { const int ch = tid + 512 * i, t = ch >> 5, cc = (ch & 31) * 8; *(LAS u32x4*)(Fs + t * 512 + cc * 2) = rr[i]; }
        }
        __syncthreads();
        const int kh = tid >> 8, c = tid & 255;
        float gr[4] = {0.f, 0.f, 0.f, 0.f}, gi[4] = {0.f, 0.f, 0.f, 0.f};
#pragma unroll 8
        for (int t = 0; t < 256; ++t) {
            const float f = bf2f(*(const LAS bf16_t*)(Fs + t * 512 + c * 2));
            const f32x4 t01 = *(const LAS f32x4*)(T + t * 8 + 4 * kh), t23 = *(const LAS f32x4*)(T + t * 8 + 4 * kh + 2);
            gr[0] += f * t01[0]; gi[0] -= f * t01[1]; gr[1] += f * t01[2]; gi[1] -= f * t01[3];
            gr[2] += f * t23[0]; gi[2] -= f * t23[1]; gr[3] += f * t23[2]; gi[3] -= f * t23[3];
        }
        __syncthreads();
#pragma unroll
        for (int q = 0; q < 4; ++q) Gs[(4 * kh + q) * 256 + c] = (f32x2){gr[q], gi[q]};
        __syncthreads();
        const int g = (tid >> 6) & 3, lx = tid & 63;
        float y[4] = {0.f, 0.f, 0.f, 0.f};
#pragma unroll 8
        for (int c2 = 0; c2 < 64; ++c2) {
            const f32x2 cs = tw[((lx * c2) & 63) * 4];
#pragma unroll
            for (int q = 0; q < 4; ++q) { const f32x2 gv = Gs[(4 * kh + q) * 256 + 64 * g + c2]; y[q] += cs.x * gv.x + cs.y * gv.y; }
        }
#pragma unroll
        for (int q = 0; q < 4; ++q) MIX[((size_t)b * TPB + kb + 4 * kh + q) * 1024 + 64 * g + lx] = f2bf(y[q] * (1.0f / 128.0f));
    }
    __syncthreads();
}

DI void phase_krope(const Args& a) {
    const bf16_t* U = (const bf16_t*)(a.ws + WS_R1); bf16_t* KR = (bf16_t*)(a.ws + WS_R2 + R2_KR); const f32x2* RP = (const f32x2*)(a.ws + WS_ROPE);
    for (int gid = bidx() * NTHR + tidx(); gid < NROW * 16; gid += gdim() * NTHR) {
        const int row = gid >> 4, i = gid & 15, pos = row % TPB;
        const unsigned w = *(const unsigned*)(U + (size_t)row * UW + U_KR + 2 * i);
        float t1 = __uint_as_float(w << 16), t2 = __uint_as_float(w & 0xffff0000u);
        if (pos >= CTXL) {
            const int tp = pos - CTXL, rr = tp >> 6, cc = tp & 63;
            const f32x2 cs = (i < 8) ? RP[rr * 8 + i] : RP[1024 + cc * 8 + (i - 8)];
            const float o1 = t1 * cs.x - t2 * cs.y, o2 = t1 * cs.y + t2 * cs.x; t1 = o1; t2 = o2;
        }
        *(unsigned*)(KR + (size_t)row * 32 + 2 * i) = pk2(t1, t2);
    }
}

DI void phase_kmax(const Args& a, LAS unsigned char* lds) {
    const int tid = tidx(), lane = tid & 63;
    const bf16_t* KN = (const bf16_t*)(a.ws + WS_R2 + R2_KN); const bf16_t* KR = (const bf16_t*)(a.ws + WS_R2 + R2_KR);
    unsigned* KMAX = (unsigned*)(a.ws + WS_R4 + R4_KMAX);
    LAS unsigned* lm = (LAS unsigned*)lds;
    const int rpb = (NROW + gdim() - 1) / gdim(), row_lo = bidx() * rpb, row_hi = (row_lo + rpb < NROW) ? row_lo + rpb : NROW;
    __syncthreads();
    if (tid < 9) lm[tid] = 0u;
    __syncthreads();
    const int b0 = row_lo / TPB;
    for (int it = tid; it < (row_hi - row_lo) * 8; it += NTHR) {
        const int row = row_lo + (it >> 3), h = it & 7, b = row / TPB;
        const u32x4* kp = (const u32x4*)(KN + (size_t)row * 512 + h * 64);
        float ss = 0.f;
#pragma unroll
        for (int q = 0; q < 8; ++q) { const u32x4 w = kp[q]; const unsigned wu[4] = {w.x, w.y, w.z, w.w};
#pragma unroll
            for (int j = 0; j < 4; ++j) { const float lo = __uint_as_float(wu[j] << 16), hi = __uint_as_float(wu[j] & 0xffff0000u); ss += lo * lo + hi * hi; } }
        float sr = 0.f;
        if (h == 0) { const u32x4* rp = (const u32x4*)(KR + (size_t)row * 32);
#pragma unroll
            for (int q = 0; q < 4; ++q) { const u32x4 w = rp[q]; const unsigned wu[4] = {w.x, w.y, w.z, w.w};
#pragma unroll
                for (int j = 0; j < 4; ++j) { const float lo = __uint_as_float(wu[j] << 16), hi = __uint_as_float(wu[j] & 0xffff0000u); sr += lo * lo + hi * hi; } } }
        if (b == b0) { __hip_atomic_fetch_max(&lm[h], __float_as_uint(ss), __ATOMIC_RELAXED, __HIP_MEMORY_SCOPE_WORKGROUP); if (h == 0) __hip_atomic_fetch_max(&lm[8], __float_as_uint(sr), __ATOMIC_RELAXED, __HIP_MEMORY_SCOPE_WORKGROUP); }
        else { atomicMax(&KMAX[b * 8 + h], __float_as_uint(ss)); if (h == 0) atomicMax(&KMAX[64 + b], __float_as_uint(sr)); }
    }
    __syncthreads();
    if (tid < 8) atomicMax(&KMAX[b0 * 8 + tid], lm[tid]);
    if (tid == 8) atomicMax(&KMAX[64 + b0], lm[8]);
    __syncthreads();
    (void)lane;
}
#ifndef REPS_P6
#define REPS_P6 1
#endif
#ifndef REPS_P3G
#define REPS_P3G 1
#endif
#ifndef REPS_P2
#define REPS_P2 1
#endif
#ifndef REPS_P10
#define REPS_P10 1
#endif
#ifndef REPS_P11
#define REPS_P11 1
#endif
#ifndef REPS_P7
#define REPS_P7 1
#endif
#ifndef REPS_P8
#define REPS_P8 1
#endif
#ifndef REPS_P9
#define REPS_P9 1
#endif
constexpr int WP_R1 = 3480, WP_R2 = 7380, WP_R3 = 9712;
constexpr int N_PHASES = 1 + 10 * DEPTH + 1;
typedef const __attribute__((address_space(4))) Args CArgs;
DI LAS unsigned char* lds_base() { extern __shared__ __attribute__((aligned(16))) unsigned char smem_raw[]; LAS unsigned char* p = (LAS unsigned char*)smem_raw; return p; }
#define LOAD_ARGS CArgs* ap2_ = ap; asm volatile("" : "+s"(ap2_)); const Args a = *(const Args*)ap2_; LAS unsigned char* lds = lds_base();

__global__ void __launch_bounds__(NTHR, 2) mega_fwd(Args a_) {
    CArgs* ap = (CArgs*)__builtin_amdgcn_kernarg_segment_ptr();
    volatile LAS unsigned* xbw = (volatile LAS unsigned*)(lds_base() + LDS_BYTES - 16);
    if (threadIdx.x == 0) { xbw[0] = 0u; xbw[1] = 0u; xbw[2] = 0u; xbw[3] = 0u; }
    __syncthreads();
    const int ph_lo = ap->ph_lo, ph_hi = ap->ph_hi;
    const bool multi = (ph_hi - ph_lo) > 1;
    XcdBarrier bar; bar.bar = (unsigned*)(ap->ws + WS_BAR); bar.x = 0; bar.st = xbw;
    if (multi) bar = xcd_barrier_post((unsigned*)(ap->ws + WS_BAR), xbw);
    int ph = 0;
#define PH_BEGIN { int lo_ = ph_lo, hi_ = ph_hi; asm volatile("" : "+s"(lo_), "+s"(hi_)); if (ph >= lo_ && ph < hi_) {
#ifdef PROBE_BAR
#define PH_END   if (ph + 1 < hi_) { xcd_barrier(bar); xcd_barrier(bar); } } } ++ph;
#else
#define PH_END   if (ph + 1 < hi_) xcd_barrier(bar); } } ++ph;
#endif
    PH_BEGIN { LOAD_ARGS phase_prologue(a, lds); }
    { LOAD_ARGS phase_wprep(a, 0, lds); }
#ifdef PROBE_PRO
    { LOAD_ARGS phase_prologue(a, lds); }
#endif
    PH_END
    for (int l = 0; l < DEPTH; ++l) {
        PH_BEGIN
#ifdef PROBE_WPREP
            { LOAD_ARGS phase_wprep(a, l, lds); }
#endif
            { LOAD_ARGS if (l == 0) phase_norm1<true, false>(a, l, lds); else phase_norm1<false, false>(a, l, lds); }
#ifdef PROBE_P1
            { LOAD_ARGS if (l == 0) phase_norm1<true, false>(a, l, lds); else phase_norm1<false, false>(a, l, lds, 0.0f); }
#endif
        PH_END
        PH_BEGIN _Pragma("nounroll") for (int rep_ = 0; rep_ < REPS_P2; ++rep_) { LOAD_ARGS
            pg8::StaticOrder S; S.init(NROW, UW, gdim(), bidx());
            pg8::Gemm g{(const bf16_t*)(a.ws + WS_XN), (const bf16_t*)(a.ws + wsw(WS_WIN, l)), NROW, UW, 1024, 1024, 1024, 1 << 30, 0, nullptr, 0};
            EpiIn E{(bf16_t*)(a.ws + WS_R1), (float*)(a.ws + WS_R4 + R4_GATES), (float*)(a.ws + WS_R4 + R4_SSQ)};
            pg8::gemm_phase(lds, g, S, E); }
            if (l < DEPTH - 1) { LOAD_ARGS const int nex_ = ((NROW / 256) * (UW / 256)) % gdim(); if (bidx() >= nex_) phase_wprep(a, l + 1, lds, 0, WP_R1, bidx() - nex_, gdim() - nex_); }
        PH_END
        PH_BEGIN
            _Pragma("nounroll") for (int rep_ = 0; rep_ < REPS_P3G; ++rep_) {
            { LOAD_ARGS
              const bool lastl = (l == DEPTH - 1); pg8::StaticOrder S; S.init(lastl ? NB * SEQ : NROW, 768, gdim(), bidx());
              pg8::Gemm g{(const bf16_t*)(a.ws + WS_R1) + U_CQ, (const bf16_t*)(a.ws + wsw(WS_WQ, l)), NROW, 768, 384, UW, 384, 1 << 30, 0, nullptr, lastl ? 1 : 0};
              EpiQ E{(bf16_t*)(a.ws + WS_R2 + R2_Q), (const float*)(a.ws + WS_R4 + R4_SSQ)};
              pg8::gemm_phase(lds, g, S, E); }
            { LOAD_ARGS
              pg8::StaticOrder S; S.init(NROW, 1024, gdim(), (bidx() + 64) % gdim());
              pg8::Gemm g{(const bf16_t*)(a.ws + WS_R1) + U_CKV, (const bf16_t*)(a.ws + wsw(WS_WKV, l)), NROW, 1024, 256, UW, 256, 1 << 30, 0, nullptr, 0};
              EpiKV E{(bf16_t*)(a.ws + WS_R2 + R2_KN), (bf16_t*)(a.ws + WS_R2 + R2_VT), (const float*)(a.ws + WS_R4 + R4_SSQ)};
              pg8::gemm_phase(lds, g, S, E); }
            }
            { LOAD_ARGS phase_krope(a); }
#ifdef PROBE_KROPE
            { LOAD_ARGS phase_krope(a); }
#endif
            { LOAD_ARGS phase_fft_a(a, lds); }
#ifdef PROBE_FFTA
            { LOAD_ARGS phase_fft_a(a, lds); }
#endif
            { LOAD_ARGS phase_mlstm_local(a, l, lds); }
#ifdef PROBE_MLOC
            { LOAD_ARGS phase_mlstm_local(a, l, lds); }
#endif
            if (l < DEPTH - 1) { LOAD_ARGS phase_cfft(a, lds); }
#ifdef PROBE_CFFT
            if (l < DEPTH - 1) { LOAD_ARGS phase_cfft(a, lds); }
#endif
        PH_END
        PH_BEGIN
            { LOAD_ARGS phase_mlstm_scan(a); }
#ifdef PROBE_SCAN
            { LOAD_ARGS phase_mlstm_scan(a); }
#endif
            { LOAD_ARGS phase_kmax(a, lds); }
#ifdef PROBE_KMAX
            { LOAD_ARGS phase_kmax(a, lds); }
#endif
        PH_END
        PH_BEGIN
            { LOAD_ARGS phase_attention(a, l, lds); }
#ifdef PROBE_ATTN
            { LOAD_ARGS phase_attention(a, l, lds); }
#endif
            { LOAD_ARGS phase_mlstm_out2(a, l, lds); }
#ifdef PROBE_MOUT
            { LOAD_ARGS phase_mlstm_out2(a, l, lds); }
#endif
            {
                LOAD_ARGS
                const int npair = ((l < DEPTH - 1) ? NB * 4 * NCHUNK : NB * 4 * (NCHUNK - 2)) / 2, nheavy = (gdim() == 256) ? npair % 256 : 0;
                const int p0 = (bidx() + 128) % gdim();
                int hv = -1, lt = -1; if (nheavy > 0) { if (p0 < nheavy) hv = p0; else lt = p0 - nheavy; }
                phase_fft_bc(a, lds, nheavy, hv, lt);
            }
#ifdef PROBE_FFTBC
            { LOAD_ARGS phase_fft_bc(a, lds); }
#endif
        PH_END
        PH_BEGIN _Pragma("nounroll") for (int rep_ = 0; rep_ < REPS_P6; ++rep_) { LOAD_ARGS
            const bool lastl = (l == DEPTH - 1); pg8::StaticOrder S; S.init(lastl ? NB * SEQ : NROW, 1024, gdim(), bidx());
            pg8::Gemm g{(const bf16_t*)(a.ws + WS_XN), (const bf16_t*)(a.ws + wsw(WS_WOUT, l)), NROW, 1024, 1024, 1024, 1024, 1 << 30, 0, nullptr, lastl ? 1 : 0};
            EpiOut E{(xres_t*)(a.ws + WS_X), (const float*)(a.ws + WS_MOD) + (size_t)l * 9 * 6144, rep_ == 0 ? 1.0f : 0.0f};
            pg8::gemm_phase(lds, g, S, E); }
            if (l < DEPTH - 1) { LOAD_ARGS const int nex_ = ((NROW / 256) * 4) % gdim(); if (bidx() >= nex_) phase_wprep(a, l + 1, lds, WP_R1, WP_R2, bidx() - nex_, gdim() - nex_); }
        PH_END
        PH_BEGIN _Pragma("nounroll") for (int rep_ = 0; rep_ < REPS_P7; ++rep_) { LOAD_ARGS phase_norm2_router(a, l, lds); } PH_END
        PH_BEGIN _Pragma("nounroll") for (int rep_ = 0; rep_ < REPS_P8; ++rep_) { LOAD_ARGS phase_topk(a, lds); } PH_END
        PH_BEGIN _Pragma("nounroll") for (int rep_ = 0; rep_ < REPS_P10; ++rep_) { LOAD_ARGS
            const bool lastl = (l == DEPTH - 1); pg8::StaticOrder S; S.init(lastl ? NEXP * NB * CAPX : NSLOT, 2048, gdim(), bidx());
            pg8::Gemm g{(const bf16_t*)(a.ws + WS_XN), (const bf16_t*)(a.ws + wsw(WS_WGU, l)), NSLOT, 2048, 1024, 1024, 1024, 33, (size_t)2048 * 1024, (const int*)(a.ws + WS_R4 + R4_SEL), lastl ? 2 : 0};
            EpiGU E{(bf16_t*)(a.ws + WS_R2)};
            pg8::gemm_phase(lds, g, S, E); }
            if (l < DEPTH - 1) { LOAD_ARGS const int nex_ = ((NSLOT / 256) * 8) % gdim(); if (bidx() >= nex_) phase_wprep(a, l + 1, lds, WP_R2, WP_R3, bidx() - nex_, gdim() - nex_); }
        PH_END
        PH_BEGIN _Pragma("nounroll") for (int rep_ = 0; rep_ < REPS_P11; ++rep_) { LOAD_ARGS
            const bool lastl = (l == DEPTH - 1); pg8::StaticOrder S; S.init(lastl ? NEXP * NB * CAPX : NSLOT, 1024, gdim(), bidx());
            pg8::Gemm g{(const bf16_t*)(a.ws + WS_R2), (const bf16_t*)(a.ws + wsw(WS_WDN, l)), NSLOT, 1024, 1024, 1024, 1024, 33, (size_t)1024 * 1024, nullptr, lastl ? 2 : 0};
            EpiDN E{(bf16_t*)(a.ws + WS_R1), (const float*)(a.ws + WS_R4 + R4_GATEV)};
            pg8::gemm_phase(lds, g, S, E); }
            if (l < DEPTH - 1) { LOAD_ARGS const int nex_ = ((NSLOT / 256) * 4) % gdim(); if (bidx() >= nex_) phase_wprep(a, l + 1, lds, WP_R3, WPREP_TILES, bidx() - nex_, gdim() - nex_); }
        PH_END
    }
    PH_BEGIN { LOAD_ARGS phase_norm1<false, true>(a, DEPTH, lds); } PH_END
#undef PH_BEGIN
#undef PH_END
    (void)a_;
}

#ifndef MK_SINGLE
#define MK_SINGLE 0
#endif
extern "C" void kernel_launch(void* const* d_in, const int* in_sizes, int n_in, void* d_out, int out_size, void* d_ws, size_t ws_size, hipStream_t stream) {
    static int grid = 0;
    if (grid == 0) {
        if (n_in != 24 || ws_size < WS_END) { fprintf(stderr, "kernel_launch: need 24 inputs and >= %zu bytes of workspace; got n_in %d, ws %zu; nothing launched\n", (size_t)WS_END, n_in, ws_size); grid = -1; return; }
        int dev = 0, cus = 0;
        if (hipGetDevice(&dev) != hipSuccess || hipDeviceGetAttribute(&cus, hipDeviceAttributeMultiprocessorCount, dev) != hipSuccess) { grid = -1; return; }
        if (hipFuncSetAttribute((const void*)mega_fwd, hipFuncAttributeMaxDynamicSharedMemorySize, LDS_BYTES) != hipSuccess) { fprintf(stderr, "kernel_launch: hipFuncSetAttribute failed\n"); grid = -1; return; }
        int per_cu = 0;
        if (hipOccupancyMaxActiveBlocksPerMultiprocessor(&per_cu, (const void*)mega_fwd, NTHR, LDS_BYTES) != hipSuccess || per_cu < 1) fprintf(stderr, "kernel_launch: occupancy query says %d\n", per_cu);
        (void)hipGetLastError();
        grid = cus;
    }
    if (grid < 0) return;
    (void)hipMemsetAsync((char*)d_ws + WS_BAR, 0, 16384, stream);
    Args a{};
    a.x = (const float*)d_in[0]; a.c = (const float*)d_in[1]; a.ctx = (const float*)d_in[2]; a.c_ctx = (const float*)d_in[3]; a.ada_w = (const float*)d_in[4]; a.ada_b = (const float*)d_in[5];
    a.norm1_g = (const float*)d_in[6]; a.norm2_g = (const float*)d_in[7]; a.w_in = (const float*)d_in[8]; a.m_conv_w = (const float*)d_in[9]; a.m_conv_b = (const float*)d_in[10];
    a.m_ib = (const float*)d_in[11]; a.m_fb = (const float*)d_in[12]; a.m_norm_g = (const float*)d_in[13]; a.a_qnorm_g = (const float*)d_in[14]; a.a_wq_up = (const float*)d_in[15];
    a.a_kvnorm_g = (const float*)d_in[16]; a.a_wkv_up = (const float*)d_in[17]; a.w_out = (const float*)d_in[18]; a.router_w = (const float*)d_in[19]; a.e_w_gate = (const float*)d_in[20];
    a.e_w_up = (const float*)d_in[21]; a.e_w_down = (const float*)d_in[22]; a.final_g = (const float*)d_in[23];
    a.out = (float*)d_out; a.ws = (unsigned char*)d_ws;
#if MK_SINGLE
    a.ph_lo = 0; a.ph_hi = N_PHASES;
    hipLaunchKernelGGL(mega_fwd, dim3(grid), dim3(NTHR), LDS_BYTES, stream, a);
#else
    for (int p = 0; p < N_PHASES; ++p) { a.ph_lo = p; a.ph_hi = p + 1; hipLaunchKernelGGL(mega_fwd, dim3(grid), dim3(NTHR), LDS_BYTES, stream, a); }
#endif
}
```
